# Optimizing an MI355X kernel written in HIP

```python
import jax
import jax.numpy as jnp
from jax import lax
import numpy as np


D_MODEL = 1024
BATCH = 8
SEQ = 4096
DEPTH = 1

CHUNK = 64
N_MEM = 256
D_MIX = D_MODEL
D_RNN = D_MIX // 2
D_ATT = D_MIX - D_RNN
N_RNN_BLOCKS = 8
RNN_BLOCK = D_RNN // N_RNN_BLOCKS
CONV_WIDTH = 4
RG_LRU_C = 8.0
N_ATT_HEADS = 8
ATT_HEAD_DIM = D_ATT // N_ATT_HEADS
LEFT_CHUNKS = 8
BAND = (LEFT_CHUNKS + 1) * CHUNK
REL_CLIP = 128
N_XHEADS = 4
XHEAD_DIM = D_MODEL // N_XHEADS
N_GROUPS = 4
EXPERTS_PER_GROUP = 8
N_EXPERTS = N_GROUPS * EXPERTS_PER_GROUP
TOP_K = 2
D_EXPERT = D_MODEL // 2
MOE_BLOCK = 128
D_IN_PROJ = 2 * D_RNN + 3 * D_ATT
EPS = 1e-6
NEG_INF = -1e30

kernel_name = 'hymba_style_streaming_hybrid_block'


def rms_norm(x, w):
    xf = x.astype(jnp.float32)
    y = xf * lax.rsqrt(jnp.mean(xf * xf, axis=-1, keepdims=True) + EPS)
    return (y * w.astype(jnp.float32)).astype(x.dtype)


def _linear_recurrence_combine(left, right):
    a1, b1 = left
    a2, b2 = right
    return a1 * a2, a2 * b1 + b2


def recurrent_group(xr, xg, conv_w, conv_b, w_a, b_a, w_x, b_x, lam):
    b, s, _ = xr.shape
    xc = lax.conv_general_dilated(
        xr, conv_w[:, None, :].astype(xr.dtype), window_strides=(1,),
        padding=[(CONV_WIDTH - 1, 0)], dimension_numbers=('NWC', 'WIO', 'NWC'),
        feature_group_count=D_RNN) + conv_b
    xb = xc.reshape(b, s, N_RNN_BLOCKS, RNN_BLOCK)
    r = jax.nn.sigmoid((jnp.einsum('bsnc,ncd->bsnd', xb, w_a).reshape(b, s, D_RNN) + b_a).astype(jnp.float32))
    i = jax.nn.sigmoid((jnp.einsum('bsnc,ncd->bsnd', xb, w_x).reshape(b, s, D_RNN) + b_x).astype(jnp.float32))
    log_a = -RG_LRU_C * r * jax.nn.softplus(-lam.astype(jnp.float32))
    a = jnp.exp(log_a)
    u = jnp.sqrt(-jnp.expm1(2.0 * log_a)) * (i * xc.astype(jnp.float32))
    _, h = lax.associative_scan(_linear_recurrence_combine, (a, u), axis=1)
    return (jax.nn.gelu(xg.astype(jnp.float32)) * h).astype(xr.dtype)


def rel_bias_band(rel_bias):
    qi = np.arange(CHUNK)[:, None]
    kj = np.arange(BAND)[None, :]
    dist = LEFT_CHUNKS * CHUNK + qi - kj
    idx = np.clip(dist, -REL_CLIP, REL_CLIP) + REL_CLIP
    return rel_bias[:, idx]


def chunk_band_attention(q, k, v, rel_bias):
    b, s, _ = q.shape
    nc = s // CHUNK
    qc = q.reshape(b, nc, CHUNK, N_ATT_HEADS, ATT_HEAD_DIM)
    kc = k.reshape(b, nc, CHUNK, N_ATT_HEADS, ATT_HEAD_DIM)
    vc = v.reshape(b, nc, CHUNK, N_ATT_HEADS, ATT_HEAD_DIM)
    pad = ((0, 0), (LEFT_CHUNKS, 0), (0, 0), (0, 0), (0, 0))
    kp = jnp.pad(kc, pad)
    vp = jnp.pad(vc, pad)
    kb = jnp.concatenate([kp[:, j:j + nc] for j in range(LEFT_CHUNKS + 1)], axis=2)
    vb = jnp.concatenate([vp[:, j:j + nc] for j in range(LEFT_CHUNKS + 1)], axis=2)
    chunk_id = np.arange(nc)[:, None] - LEFT_CHUNKS + np.arange(LEFT_CHUNKS + 1)[None, :]
    valid = np.repeat(chunk_id >= 0, CHUNK, axis=1)
    scores = jnp.einsum('bnqhd,bnkhd->bhnqk', qc, kb, preferred_element_type=jnp.float32)
    scores = scores * (ATT_HEAD_DIM ** -0.5) + rel_bias_band(rel_bias).astype(jnp.float32)[None, :, None]
    scores = jnp.where(valid[None, None, :, None, :], scores, NEG_INF)
    probs = jax.nn.softmax(scores, axis=-1).astype(v.dtype)
    out = jnp.einsum('bhnqk,bnkhd->bnqhd', probs, vb)
    return out.reshape(b, s, D_ATT)


def memory_cross_attention(h, mem_n, wq, wk, wv, wo):
    b, s, _ = h.shape
    m = mem_n.shape[1]
    q = (h @ wq).reshape(b, s, N_XHEADS, XHEAD_DIM)
    k = (mem_n @ wk).reshape(b, m, N_XHEADS, XHEAD_DIM)
    v = (mem_n @ wv).reshape(b, m, N_XHEADS, XHEAD_DIM)
    scores = jnp.einsum('bshd,bmhd->bhsm', q, k, preferred_element_type=jnp.float32) * (XHEAD_DIM ** -0.5)
    probs = jax.nn.softmax(scores, axis=-1).astype(v.dtype)
    out = jnp.einsum('bhsm,bmhd->bshd', probs, v).reshape(b, s, D_MODEL)
    return out @ wo


def routed_experts(ht, expert_idx, combine_w, w_gate, w_up, w_down):
    t, d = ht.shape
    n_slots = t * TOP_K
    flat_e = expert_idx.reshape(-1)
    flat_tok = jnp.repeat(jnp.arange(t, dtype=jnp.int32), TOP_K)
    order = jnp.argsort(flat_e)
    e_sorted = flat_e[order]
    tok_sorted = flat_tok[order]
    w_sorted = combine_w.reshape(-1)[order]
    counts = jnp.bincount(flat_e, length=N_EXPERTS)
    padded = (counts + MOE_BLOCK - 1) // MOE_BLOCK * MOE_BLOCK
    pad_end = jnp.cumsum(padded)
    pad_start = pad_end - padded
    start = jnp.cumsum(counts) - counts
    dest = pad_start[e_sorted] + (jnp.arange(n_slots) - start[e_sorted])
    n_blocks = (n_slots + MOE_BLOCK - 1) // MOE_BLOCK + N_EXPERTS
    n_rows = n_blocks * MOE_BLOCK
    src_tok = jnp.full((n_rows,), t, dtype=jnp.int32).at[dest].set(tok_sorted)
    x_pad = jnp.concatenate([ht, jnp.zeros((1, d), ht.dtype)], axis=0)
    xs = x_pad[src_tok].reshape(n_blocks, MOE_BLOCK, d)
    block_expert = jnp.minimum(
        jnp.searchsorted(pad_end, jnp.arange(n_blocks) * MOE_BLOCK, side='right'), N_EXPERTS - 1)

    def expert_block(args):
        xb, e = args
        g = xb @ w_gate[e]
        u = xb @ w_up[e]
        return (jax.nn.silu(g) * u) @ w_down[e]

    ys = lax.map(expert_block, (xs, block_expert)).reshape(n_rows, d)
    contrib = (ys[dest].astype(jnp.float32) * w_sorted[:, None]).astype(ht.dtype)
    return jnp.zeros((t, d), ht.dtype).at[tok_sorted].add(contrib)


def hierarchical_moe(h, w_group, b_group, w_router, b_router, w_gate, w_up, w_down):
    b, s, d = h.shape
    t = b * s
    ht = h.reshape(t, d)
    g_logits = (ht @ w_group).astype(jnp.float32) + b_group.astype(jnp.float32)
    g_probs = jax.nn.softmax(g_logits, axis=-1)
    g_p, g_idx = lax.top_k(g_probs, 1)
    e_all = jnp.einsum('td,gde->tge', ht, w_router).astype(jnp.float32) + b_router.astype(jnp.float32)
    sel = jnp.broadcast_to(g_idx[:, :, None], (t, 1, EXPERTS_PER_GROUP))
    e_logits = jnp.take_along_axis(e_all, sel, axis=1)[:, 0]
    e_probs = jax.nn.softmax(e_logits, axis=-1)
    e_p, e_idx = lax.top_k(e_probs, TOP_K)
    e_p = e_p / jnp.sum(e_p, axis=-1, keepdims=True)
    combine_w = g_p * e_p
    expert_idx = g_idx * EXPERTS_PER_GROUP + e_idx
    y = routed_experts(ht, expert_idx, combine_w, w_gate, w_up, w_down)
    return y.reshape(b, s, d)


def setup_inputs(seed: int = 0) -> dict:
    key = jax.random.key(seed)
    ks = jax.random.split(key, 32)
    f32 = jnp.float32

    def nrm(k, shape, scale):
        return jax.random.normal(k, shape, f32) * scale

    def gain(k, shape):
        return 1.0 + 0.02 * jax.random.normal(k, shape, f32)

    a0 = jax.random.uniform(ks[10], (DEPTH, D_RNN), f32, 0.9, 0.999)
    lam = jnp.log(a0) - jnp.log1p(-a0)
    return {
        'x': nrm(ks[0], (BATCH, SEQ, D_MODEL), 1.0),
        'mem': nrm(ks[1], (BATCH, N_MEM, D_MODEL), 1.0),
        'ln1_w': gain(ks[2], (DEPTH, D_MODEL)),
        'w_in': nrm(ks[3], (DEPTH, D_MODEL, D_IN_PROJ), D_MODEL ** -0.5),
        'conv_w': nrm(ks[4], (DEPTH, CONV_WIDTH, D_RNN), CONV_WIDTH ** -0.5),
        'conv_b': nrm(ks[5], (DEPTH, D_RNN), 0.02),
        'rnn_wa': nrm(ks[6], (DEPTH, N_RNN_BLOCKS, RNN_BLOCK, RNN_BLOCK), RNN_BLOCK ** -0.5),
        'rnn_ba': nrm(ks[7], (DEPTH, D_RNN), 0.02),
        'rnn_wx': nrm(ks[8], (DEPTH, N_RNN_BLOCKS, RNN_BLOCK, RNN_BLOCK), RNN_BLOCK ** -0.5),
        'rnn_bx': nrm(ks[9], (DEPTH, D_RNN), 0.02),
        'rnn_lambda': lam,
        'rel_bias': nrm(ks[11], (DEPTH, N_ATT_HEADS, 2 * REL_CLIP + 1), 0.2),
        'gn_rnn_w': gain(ks[12], (DEPTH, D_RNN)),
        'gn_att_w': gain(ks[13], (DEPTH, D_ATT)),
        'w_out': nrm(ks[14], (DEPTH, D_MIX, D_MODEL), D_MIX ** -0.5),
        'ln2_w': gain(ks[15], (DEPTH, D_MODEL)),
        'mem_norm_w': gain(ks[16], (D_MODEL,)),
        'xq_w': nrm(ks[17], (DEPTH, D_MODEL, D_MODEL), D_MODEL ** -0.5),
        'xk_w': nrm(ks[18], (DEPTH, D_MODEL, D_MODEL), D_MODEL ** -0.5),
        'xv_w': nrm(ks[19], (DEPTH, D_MODEL, D_MODEL), D_MODEL ** -0.5),
        'xo_w': nrm(ks[20], (DEPTH, D_MODEL, D_MODEL), D_MODEL ** -0.5),
        'ln3_w': gain(ks[21], (DEPTH, D_MODEL)),
        'router_group_w': nrm(ks[22], (DEPTH, D_MODEL, N_GROUPS), D_MODEL ** -0.5),
        'router_group_b': nrm(ks[23], (DEPTH, N_GROUPS), 0.01),
        'router_expert_w': nrm(ks[24], (DEPTH, N_GROUPS, D_MODEL, EXPERTS_PER_GROUP), D_MODEL ** -0.5),
        'router_expert_b': nrm(ks[25], (DEPTH, N_GROUPS, EXPERTS_PER_GROUP), 0.01),
        'expert_gate_w': nrm(ks[26], (DEPTH, N_EXPERTS, D_MODEL, D_EXPERT), D_MODEL ** -0.5),
        'expert_up_w': nrm(ks[27], (DEPTH, N_EXPERTS, D_MODEL, D_EXPERT), D_MODEL ** -0.5),
        'expert_down_w': nrm(ks[28], (DEPTH, N_EXPERTS, D_EXPERT, D_MODEL), D_EXPERT ** -0.5),
        'final_norm_w': gain(ks[29], (D_MODEL,)),
    }


def reference(x, mem, ln1_w, w_in, conv_w, conv_b, rnn_wa, rnn_ba, rnn_wx, rnn_bx, rnn_lambda,
              rel_bias, gn_rnn_w, gn_att_w, w_out, ln2_w, mem_norm_w, xq_w, xk_w, xv_w, xo_w,
              ln3_w, router_group_w, router_group_b, router_expert_w, router_expert_b,
              expert_gate_w, expert_up_w, expert_down_w, final_norm_w):
    mem_n = rms_norm(mem, mem_norm_w)
    for l in range(DEPTH):
        h = rms_norm(x, ln1_w[l])
        proj = h @ w_in[l]
        xr = proj[..., :D_RNN]
        xg = proj[..., D_RNN:2 * D_RNN]
        q = proj[..., 2 * D_RNN:2 * D_RNN + D_ATT]
        k = proj[..., 2 * D_RNN + D_ATT:2 * D_RNN + 2 * D_ATT]
        v = proj[..., 2 * D_RNN + 2 * D_ATT:]
        y_rnn = recurrent_group(xr, xg, conv_w[l], conv_b[l], rnn_wa[l], rnn_ba[l],
                                rnn_wx[l], rnn_bx[l], rnn_lambda[l])
        y_att = chunk_band_attention(q, k, v, rel_bias[l])
        mixed = jnp.concatenate([rms_norm(y_rnn, gn_rnn_w[l]), rms_norm(y_att, gn_att_w[l])], axis=-1)
        x = x + mixed @ w_out[l]
        h = rms_norm(x, ln2_w[l])
        x = x + memory_cross_attention(h, mem_n, xq_w[l], xk_w[l], xv_w[l], xo_w[l])
        h = rms_norm(x, ln3_w[l])
        x = x + hierarchical_moe(h, router_group_w[l], router_group_b[l], router_expert_w[l],
                                 router_expert_b[l], expert_gate_w[l], expert_up_w[l], expert_down_w[l])
    return rms_norm(x, final_norm_w)
```

```cpp
#include <hip/hip_runtime.h>
#include <cstdio>
#include <cstdint>

#ifndef MK_N_LAUNCHES
#define MK_N_LAUNCHES 1
#endif

#define LAS __attribute__((address_space(3)))
#define GAS __attribute__((address_space(1)))
typedef unsigned short bf16;
typedef short bf16x8 __attribute__((ext_vector_type(8)));
typedef short s16x4 __attribute__((ext_vector_type(4)));
typedef float f32x4 __attribute__((ext_vector_type(4)));
typedef float f32x16 __attribute__((ext_vector_type(16)));
typedef unsigned u32x4 __attribute__((ext_vector_type(4)));
typedef unsigned u32x2 __attribute__((ext_vector_type(2)));
typedef GAS unsigned gu32;

constexpr int BATCH = 8, SEQ = 4096, DM = 1024, T = BATCH * SEQ;
constexpr int NMEM = 256, MT = BATCH * NMEM;
constexpr int DRNN = 512, DATT = 512, NH = 8, HD = 64, CHUNK = 64, NCHUNK = SEQ / CHUNK, LEFT = 8;
constexpr int DIN = 2 * DRNN + 3 * DATT;
constexpr int XH = 4, XD = 256;
constexpr int NE = 32, DE = 512, NGRP = 4, EPG = 8;
constexpr float EPS = 1e-6f;
constexpr int NWAVES = 8, NTHR = 512;

constexpr size_t MiB = 1u << 20;
constexpr size_t WS_CTL = 0, CTL_ZERO_BYTES = 1 * MiB;
constexpr size_t WS_RSTD1 = 1 * MiB;
constexpr size_t WS_SSQR = 2 * MiB;
constexpr size_t WS_SSQA = 6 * MiB;
constexpr size_t WS_SSQ1 = 7 * MiB;
constexpr size_t WS_SSQ2 = 9 * MiB;
constexpr size_t WS_SLOTW = 11 * MiB;
constexpr size_t WS_LIST = 12 * MiB;
constexpr size_t WS_WIN = 16 * MiB;
constexpr size_t WS_WKV = 21 * MiB;
constexpr size_t WS_WOUT = 25 * MiB;
constexpr size_t WS_WQ = 27 * MiB;
constexpr size_t WS_WO = 29 * MiB;
constexpr size_t WS_WR = 31 * MiB;
constexpr size_t WS_WGU = 32 * MiB;
constexpr size_t WS_WD = 96 * MiB;
constexpr size_t WS_XB = 128 * MiB;
constexpr size_t WS_PROJ = 192 * MiB;
constexpr size_t WS_X1 = 192 * MiB;
constexpr size_t WS_YSLOT = 192 * MiB;
constexpr size_t WS_HID = 320 * MiB;
constexpr size_t WS_YMIX = 352 * MiB;
constexpr size_t WS_QX = 352 * MiB;
constexpr size_t WS_MEMN = 416 * MiB;
constexpr size_t WS_O = 416 * MiB;
constexpr size_t WS_KV = 480 * MiB;
constexpr size_t WS_END = 488 * MiB;
constexpr int HID_ROWS = 2 * T + NE * 256;

constexpr int CW_CNT = 64;
constexpr int CW_BAR = 4096;

constexpr int RING_BYTES = 131072;
constexpr int LDS_TOK = RING_BYTES;
constexpr int LDS_MISC = RING_BYTES + 8192;
constexpr int LDS_BYTES = 147456;

#define RLX_AGENT __ATOMIC_RELAXED, __HIP_MEMORY_SCOPE_AGENT
#define LDS_WAIT() asm volatile("s_waitcnt lgkmcnt(0)" ::: "memory")
#define VM_WAIT() asm volatile("s_waitcnt vmcnt(0)" ::: "memory")

__device__ __forceinline__ unsigned f2bf(float f) { unsigned u = __builtin_bit_cast(unsigned, f); return (u + 0x7fffu + ((u >> 16) & 1u)) >> 16; }
__device__ __forceinline__ unsigned pk2(float lo, float hi) { return f2bf(lo) | (f2bf(hi) << 16); }
__device__ __forceinline__ float bf2f(unsigned short b) { return __builtin_bit_cast(float, (unsigned)b << 16); }
__device__ __forceinline__ float bflo(unsigned w) { return __builtin_bit_cast(float, w << 16); }
__device__ __forceinline__ float bfhi(unsigned w) { return __builtin_bit_cast(float, w & 0xffff0000u); }

namespace pg8 {
constexpr int BM = 256, BK = 64, HALF = 128, HTB = HALF * BK * 2, STAGE_BYTES = 8 * HTB, NXCD = 8, WGM = 8;
__host__ __device__ __forceinline__ int lds_byte(int r, int c) { const int st = (r >> 4) * 2 + (c >> 5), rr = r & 15, cc = c & 31, ob = rr * 64 + cc * 2; return st * 1024 + (ob ^ (((ob >> 9) & 1) << 5)); }
__host__ __device__ __forceinline__ void stage_rc(int b, int& R, int& C) { const int st = b / 1024, sb = b % 1024, swz = sb ^ (((sb >> 9) & 1) << 5); R = (st >> 1) * 16 + swz / 64; C = (st & 1) * 32 + (swz % 64) / 2; }
__host__ __device__ __forceinline__ int perm32(int rho) { const int n = rho >> 4, i = rho & 15; return 8 * (i >> 2) + 4 * n + (i & 3); }

struct Unit { int pm, pn, aux, idx; };

struct StaticOrder {
    int nM, nN, nwg, G, c;
    __device__ void init(int M, int N, int G_, int c_) { nM = M / BM; nN = N / BM; nwg = nM * nN; G = G_; c = c_; }
    __device__ bool next(int i, Unit& u) const {
        const long L = (long)i * G + c; if (L >= nwg) return false;
        int wgid = (int)L; { const int q = nwg / NXCD, r = nwg % NXCD, xcd = wgid % NXCD, off = wgid / NXCD; wgid = (xcd < r ? xcd * (q + 1) : r * (q + 1) + (xcd - r) * q) + off; }
        const int nig = WGM * nN, gid = wgid / nig, fm = gid * WGM, gsz = (nM - fm) < WGM ? (nM - fm) : WGM;
        u.pm = fm + ((wgid % nig) % gsz); u.pn = (wgid % nig) / gsz; u.aux = 0; u.idx = i; return true;
    }
};
struct TwoHalfOrder {
    StaticOrder s;
    __device__ bool next(int i, Unit& u) const { if (!s.next(i >> 1, u)) return false; u.aux = i & 1; u.idx = i; return true; }
};

__device__ __forceinline__ unsigned cvt_pk_bf16(float lo, float hi) { unsigned r; asm volatile("v_cvt_pk_bf16_f32 %0, %1, %2" : "=v"(r) : "v"(lo), "v"(hi)); return r; }

struct DenseG {
    const bf16* A; const bf16* Bt; int lda, ldb, nt, kaux;
    static constexpr bool GATHER = false;
    __device__ __forceinline__ const char* a_base(const Unit& u) const { return (const char*)(A + (size_t)u.pm * BM * lda + (size_t)u.aux * kaux); }
    __device__ __forceinline__ const char* b_base(const Unit& u) const { return (const char*)(Bt + (size_t)u.pn * BM * ldb + (size_t)u.aux * kaux); }
    __device__ __forceinline__ void a_voff(const Unit&, const int (&R)[2], const int (&C)[2], unsigned (&v)[2][2], const LAS int*) const {
#pragma unroll
        for (int h = 0; h < 2; ++h)
#pragma unroll
            for (int i = 0; i < 2; ++i) v[h][i] = (unsigned)((h * HALF + R[i]) * lda + C[i]) * 2u;
    }
};

template <class G, class Epi, class Sched, bool ALIGN_EPI>
__device__ __forceinline__ void gemm_phase(LAS unsigned char* lds, const LAS int* ltok, const G& g, const Sched& S, const Epi& E) {
    const int tid = threadIdx.x, wid = __builtin_amdgcn_readfirstlane(tid >> 6), lane = tid & 63, wr = wid >> 2, wc = wid & 3, fr = lane & 15, fq = lane >> 4;
    const int nt = g.nt;
    int Rs[2], Cs[2]; unsigned voffB[2];
#pragma unroll
    for (int i = 0; i < 2; ++i) { stage_rc(tid * 16 + i * 8192, Rs[i], Cs[i]); const int Rb = Epi::PERM ? ((Rs[i] & ~31) + perm32(Rs[i] & 31)) : Rs[i];
        voffB[i] = (unsigned)(Rb * g.ldb + Cs[i]) * 2u; }
    const size_t kstep = (size_t)(BK * 2);
    const size_t hstepB = (size_t)HALF * g.ldb * 2;
    const unsigned ldsw = (unsigned)wid * 1024u;
    const int aoff = lds_byte(wr * 64 + fr, fq * 8), boff = lds_byte(wc * 32 + fr, fq * 8);
#define PG8_SA(b, h) (((b) * 2 + (h)) * HTB)
#define PG8_SB(b, h) ((4 + (b) * 2 + (h)) * HTB)
#define PG8_STAGE_A(bufoff, gbase, VO, h) do { _Pragma("unroll") for (int _i = 0; _i < 2; ++_i) \
        __builtin_amdgcn_global_load_lds((const unsigned*)((const char*)(gbase) + (VO)[h][_i]), (LAS unsigned*)(lds + (bufoff) + ldsw + _i * 8192), 16, 0, 0); } while (0)
#define PG8_STAGE_B(bufoff, gbase) do { _Pragma("unroll") for (int _i = 0; _i < 2; ++_i) \
        __builtin_amdgcn_global_load_lds((const unsigned*)((const char*)(gbase) + voffB[_i]), (LAS unsigned*)(lds + (bufoff) + ldsw + _i * 8192), 16, 0, 0); } while (0)
#define PG8_LDA(dst, b, h) do { _Pragma("unroll") for (int m = 0; m < 4; ++m) _Pragma("unroll") for (int k = 0; k < 2; ++k) dst[m][k] = *(const LAS bf16x8*)(lds + PG8_SA(b, h) + aoff + m * 2048 + k * 1024); } while (0)
#define PG8_LDB(dst, b, h) do { _Pragma("unroll") for (int n = 0; n < 2; ++n) _Pragma("unroll") for (int k = 0; k < 2; ++k) dst[n][k] = *(const LAS bf16x8*)(lds + PG8_SB(b, h) + boff + n * 2048 + k * 1024); } while (0)
#define PG8_MMA(ai, bj, At, Bt) do { __builtin_amdgcn_s_setprio(1); _Pragma("unroll") for (int m = 0; m < 4; ++m) _Pragma("unroll") for (int n = 0; n < 2; ++n) _Pragma("unroll") for (int k = 0; k < 2; ++k) \
        acc[ai][bj][m][n] = __builtin_amdgcn_mfma_f32_16x16x32_bf16(Bt[n][k], At[m][k], acc[ai][bj][m][n], 0, 0, 0); __builtin_amdgcn_s_setprio(0); } while (0)
#define PG8_WAIT_V(n) asm volatile("s_waitcnt vmcnt(" #n ")" ::: "memory")
#define PG8_WAIT_L(n) asm volatile("s_waitcnt lgkmcnt(" #n ")" ::: "memory")
#define PG8_BAR __builtin_amdgcn_s_barrier()
#define PG8_SCHED __builtin_amdgcn_sched_barrier(0)
    Unit cur, nxt; int ui = 0;
    if (!S.next(0, cur)) return;
    f32x4 acc[2][2][4][2];
#pragma unroll
    for (int a = 0; a < 2; ++a)
#pragma unroll
        for (int b = 0; b < 2; ++b)
#pragma unroll
            for (int m = 0; m < 4; ++m)
#pragma unroll
                for (int n = 0; n < 2; ++n) acc[a][b][m][n] = (f32x4){0.f, 0.f, 0.f, 0.f};
    bf16x8 At[4][2], B0[2][2], B1[2][2];
    unsigned voAc[2][2], voAn[2][2];
    g.a_voff(cur, Rs, Cs, voAc, ltok);
    const char* cA = g.a_base(cur); const char* cB = g.b_base(cur);
    PG8_STAGE_B(PG8_SB(0, 0), cB); PG8_STAGE_B(PG8_SB(0, 1), cB + hstepB); PG8_STAGE_A(PG8_SA(0, 0), cA, voAc, 0); PG8_STAGE_A(PG8_SA(0, 1), cA, voAc, 1);
    if (wr == 1) PG8_BAR;
    PG8_WAIT_V(2); PG8_BAR;
    PG8_STAGE_B(PG8_SB(1, 0), cB + kstep); PG8_STAGE_A(PG8_SA(1, 0), cA + kstep, voAc, 0); PG8_STAGE_B(PG8_SB(1, 1), cB + hstepB + kstep);
    PG8_WAIT_V(6); PG8_BAR;
    for (;;) {
        const bool has_next = S.next(ui + 1, nxt);
        const char* nA = cA; const char* nB = cB;
        if (has_next) { nA = g.a_base(nxt); nB = g.b_base(nxt); g.a_voff(nxt, Rs, Cs, voAn, ltok); }
        else {
#pragma unroll
            for (int h = 0; h < 2; ++h)
#pragma unroll
                for (int i = 0; i < 2; ++i) voAn[h][i] = voAc[h][i]; }
        for (int t = 0; t < nt; t += 2) {
            const bool last = (t == nt - 2);
            const char* a1 = cA + (size_t)(t + 1) * kstep;
            const char* a2 = last ? nA : cA + (size_t)(t + 2) * kstep; const char* b2 = last ? nB : cB + (size_t)(t + 2) * kstep;
            const char* a3 = a2 + kstep; const char* b3 = b2 + kstep;
            unsigned vo2[2][2];
#pragma unroll
            for (int h = 0; h < 2; ++h)
#pragma unroll
                for (int i = 0; i < 2; ++i) vo2[h][i] = last ? voAn[h][i] : voAc[h][i];
            PG8_LDB(B0, 0, 0); PG8_LDB(B1, 0, 1); PG8_SCHED; PG8_LDA(At, 0, 0); PG8_STAGE_A(PG8_SA(1, 1), a1, voAc, 1);
            PG8_WAIT_V(8); PG8_WAIT_L(0); PG8_BAR; PG8_MMA(0, 0, At, B0); PG8_MMA(0, 1, At, B1); PG8_BAR; PG8_SCHED;
            PG8_LDA(At, 0, 1); PG8_STAGE_B(PG8_SB(0, 0), b2); PG8_STAGE_B(PG8_SB(0, 1), b2 + hstepB); PG8_STAGE_A(PG8_SA(0, 0), a2, vo2, 0);
            PG8_WAIT_V(8); PG8_WAIT_L(0); PG8_BAR; PG8_MMA(1, 0, At, B0); PG8_MMA(1, 1, At, B1); PG8_BAR; PG8_SCHED;
            PG8_LDB(B0, 1, 0); PG8_LDB(B1, 1, 1); PG8_SCHED; PG8_LDA(At, 1, 0); PG8_STAGE_A(PG8_SA(0, 1), a2, vo2, 1);
            PG8_WAIT_V(8); PG8_WAIT_L(0); PG8_BAR; PG8_MMA(0, 0, At, B0); PG8_MMA(0, 1, At, B1); PG8_BAR; PG8_SCHED;
            PG8_LDA(At, 1, 1); PG8_STAGE_B(PG8_SB(1, 0), b3); PG8_STAGE_B(PG8_SB(1, 1), b3 + hstepB); PG8_STAGE_A(PG8_SA(1, 0), a3, vo2, 0);
            PG8_WAIT_V(8); PG8_WAIT_L(0); PG8_BAR; PG8_MMA(1, 0, At, B0); PG8_MMA(1, 1, At, B1); PG8_BAR; PG8_SCHED;
        }
        if constexpr (ALIGN_EPI) { if (wr == 0) PG8_BAR; }
        const bool keep = E(acc, cur, wr, wc, fr, fq);
        if (!has_next) break;
        if (!keep) {
#pragma unroll
            for (int a = 0; a < 2; ++a)
#pragma unroll
                for (int b = 0; b < 2; ++b)
#pragma unroll
                    for (int m = 0; m < 4; ++m)
#pragma unroll
                        for (int n = 0; n < 2; ++n) acc[a][b][m][n] = (f32x4){0.f, 0.f, 0.f, 0.f};
        }
        cur = nxt; cA = nA; cB = nB; ++ui;
#pragma unroll
        for (int h = 0; h < 2; ++h)
#pragma unroll
            for (int i = 0; i < 2; ++i) voAc[h][i] = voAn[h][i];
        if constexpr (ALIGN_EPI) { if (wr == 1) PG8_BAR; }
    }
    PG8_WAIT_V(0);
    if constexpr (!ALIGN_EPI) { if (wr == 0) PG8_BAR; }
    PG8_BAR;
#undef PG8_SA
#undef PG8_SB
#undef PG8_STAGE_A
#undef PG8_STAGE_B
#undef PG8_LDA
#undef PG8_LDB
#undef PG8_MMA
#undef PG8_WAIT_V
#undef PG8_WAIT_L
#undef PG8_BAR
#undef PG8_SCHED
}
}

#define XB_TMO      128
#define XB_XCNT(j)  (256  + 64 * (j))
#define XB_XSUB(j)  (1280 + 64 * (j))
#define XB_XGEN(j)  (2304 + 64 * (j))
#define XB_TOP      3328
#define XB_TOPGEN   3392
#define XCD_BAR_WORDS 3456
#define XB_SPIN_CAP (1u << 18)
__device__ __forceinline__ unsigned xb_ld(unsigned* p)              { return __hip_atomic_load(p, __ATOMIC_RELAXED, __HIP_MEMORY_SCOPE_AGENT); }
__device__ __forceinline__ unsigned xb_add(unsigned* p, unsigned v) { return __hip_atomic_fetch_add(p, v, __ATOMIC_RELAXED, __HIP_MEMORY_SCOPE_AGENT); }
__device__ __forceinline__ unsigned xb_xcc_id() { return (unsigned)__builtin_amdgcn_s_getreg((3 << 11) | 20) & 0xFu; }
#define XB_SPIN(cond, bar) do { unsigned _sp = 0; while (cond) { __builtin_amdgcn_s_sleep(1); \
    if ((++_sp & 255u) == 0u) { if (xb_ld(&(bar)[XB_TMO])) break; if (_sp > XB_SPIN_CAP) { atomicAdd(&(bar)[XB_TMO], 1u); break; } } } } while (0)
struct XcdBarrier { unsigned* bar; unsigned x; volatile LAS unsigned* st; };
__device__ __forceinline__ XcdBarrier xcd_barrier_post(unsigned* bar, volatile LAS unsigned* st) {
    XcdBarrier b; b.bar = bar; b.x = xb_xcc_id(); b.st = st;
    if (threadIdx.x == 0) (void)xb_add(&bar[XB_XCNT(b.x)], 1u);
    return b;
}
__device__ __forceinline__ void xcd_barrier_complete(unsigned* bar, unsigned x, unsigned& nloc, unsigned& nx) {
    const unsigned G = gridDim.x * gridDim.y * gridDim.z;
    unsigned sum, cnt, mine, sp = 0u;
    for (;;) {
        sum = 0u; cnt = 0u; mine = 0u;
#pragma unroll
        for (unsigned j = 0; j < 16; ++j) { const unsigned c = xb_ld(&bar[XB_XCNT(j)]); sum += c; cnt += (c > 0u) ? 1u : 0u; mine = (j == x) ? c : mine; }
        if (sum == G) break;
        __builtin_amdgcn_s_sleep(1);
        if ((++sp & 255u) == 0u) { if (xb_ld(&bar[XB_TMO])) break; if (sp > XB_SPIN_CAP) { atomicAdd(&bar[XB_TMO], 1u); break; } }
    }
    nloc = mine > 0u ? mine : 1u; nx = cnt > 0u ? cnt : 1u;
}
__device__ __forceinline__ void xcd_barrier(const XcdBarrier& b) {
    asm volatile("s_waitcnt vmcnt(0)" ::: "memory");
    __syncthreads();
    if (threadIdx.x == 0) {
        unsigned* bar = b.bar;
        __builtin_amdgcn_s_waitcnt(0);
        unsigned nloc = b.st[0], nx = b.st[1];
        if (nloc == 0u) { xcd_barrier_complete(bar, b.x, nloc, nx); b.st[0] = nloc; b.st[1] = nx; }
        const unsigned old = xb_add(&bar[XB_XSUB(b.x)], 1u);
        const unsigned gen = old / nloc;
        if (old + 1u == (gen + 1u) * nloc) {
            __builtin_amdgcn_fence(__ATOMIC_RELEASE, "agent");
            asm volatile("s_waitcnt vmcnt(0)" ::: "memory");
            const unsigned og = xb_add(&bar[XB_TOP], 1u);
            const unsigned tg = og / nx;
            if (og + 1u == (tg + 1u) * nx) xb_add(&bar[XB_TOPGEN], 1u);
            else XB_SPIN(xb_ld(&bar[XB_TOPGEN]) == tg, bar);
            __builtin_amdgcn_fence(__ATOMIC_ACQUIRE, "agent");
            xb_add(&bar[XB_XGEN(b.x)], 1u);
            asm volatile("s_waitcnt vmcnt(0)" ::: "memory");
        } else {
            XB_SPIN(xb_ld(&bar[XB_XGEN(b.x)]) == gen, bar);
            __builtin_amdgcn_fence(__ATOMIC_ACQUIRE, "agent");
            asm volatile("s_waitcnt vmcnt(0)" ::: "memory");
        }
    }
    __syncthreads();
}

struct Args { const float* in[30]; float* out; unsigned char* ws; int ph_lo, ph_hi; };
struct Frame {
    LAS unsigned char* lds;
    int tid, lane, wave, vcu, G;
    const float* const* in;
    unsigned char* ws; float* out;
};
__device__ __forceinline__ float wave_sum(float v) {
#pragma unroll
    for (int o = 1; o < 64; o <<= 1) v += __shfl_xor(v, o);
    return v;
}

__device__ __forceinline__ void p0_tr_item(const float* W, int N, int k0, int n0, const float* sk, float cs, bf16* WT, int ldt, int drow0, LAS float* scr, int lane) {
#pragma unroll 8
    for (int i = 0; i < 32; ++i) { const int kk = 2 * i + (lane >> 5); const float s = (sk ? sk[k0 + kk] : 1.0f) * cs;
        scr[kk * 33 + (lane & 31)] = W[(size_t)(k0 + kk) * N + n0 + (lane & 31)] * s; }
    LDS_WAIT(); asm volatile("" ::: "memory");
    const int c = lane & 7;
#pragma unroll
    for (int j = 0; j < 4; ++j) { const int n = (lane >> 3) + 8 * j; const LAS float* s = scr + (8 * c) * 33 + n;
        u32x4 o; o.x = pk2(s[0 * 33], s[1 * 33]); o.y = pk2(s[2 * 33], s[3 * 33]); o.z = pk2(s[4 * 33], s[5 * 33]); o.w = pk2(s[6 * 33], s[7 * 33]);
        *(u32x4*)(WT + (size_t)(drow0 + n) * ldt + k0 + 8 * c) = o; }
    LDS_WAIT(); asm volatile("" ::: "memory");
}
__device__ __forceinline__ void p0_prologue(Frame& F) {
    LAS float* scr = (LAS float*)(F.lds + F.wave * 16384);
    const int gw = F.vcu * NWAVES + F.wave, NGW = F.G * NWAVES, lane = F.lane;
    unsigned char* ws = F.ws;
    bf16* WinT = (bf16*)(ws + WS_WIN); bf16* WkvT = (bf16*)(ws + WS_WKV); bf16* WoutT = (bf16*)(ws + WS_WOUT); bf16* WqT = (bf16*)(ws + WS_WQ);
    bf16* WoT = (bf16*)(ws + WS_WO); bf16* WguT = (bf16*)(ws + WS_WGU); bf16* WdT = (bf16*)(ws + WS_WD);
    constexpr int I_IN = 16 * 80, I_SQ = 16 * 32, I_GU = NE * 16 * 16, I_D = NE * 8 * 32;
    constexpr int NITEMS = I_IN + 5 * I_SQ + 2 * I_GU + I_D;
    for (int it = gw; it < NITEMS; it += NGW) {
        int r = it;
        if (r < I_IN) { const int kb = r / 80, nb = r % 80, n0 = nb * 32; const float cs = (n0 >= 1024 && n0 < 1536) ? 0.125f : 1.0f;
            p0_tr_item(F.in[3], DIN, kb * 64, n0, F.in[2], cs, WinT, DM, n0, scr, lane); continue; } r -= I_IN;
        if (r < I_SQ) { const int kb = r / 32, nb = r % 32; const float* sk = (kb < 8) ? F.in[12] : (F.in[13] - 512);
            p0_tr_item(F.in[14], DM, kb * 64, nb * 32, sk, 1.0f, WoutT, DM, nb * 32, scr, lane); continue; } r -= I_SQ;
        if (r < I_SQ) { const int kb = r / 32, nb = r % 32; p0_tr_item(F.in[17], DM, kb * 64, nb * 32, F.in[15], 0.0625f, WqT, DM, nb * 32, scr, lane); continue; } r -= I_SQ;
        if (r < I_SQ) { const int kb = r / 32, nb = r % 32; p0_tr_item(F.in[18], DM, kb * 64, nb * 32, nullptr, 1.0f, WkvT, DM, nb * 32, scr, lane); continue; } r -= I_SQ;
        if (r < I_SQ) { const int kb = r / 32, nb = r % 32; p0_tr_item(F.in[19], DM, kb * 64, nb * 32, nullptr, 1.0f, WkvT, DM, 1024 + nb * 32, scr, lane); continue; } r -= I_SQ;
        if (r < I_SQ) { const int kb = r / 32, nb = r % 32; p0_tr_item(F.in[20], DM, kb * 64, nb * 32, nullptr, 1.0f, WoT, DM, nb * 32, scr, lane); continue; } r -= I_SQ;
        if (r < 2 * I_GU) { const int up = r / I_GU; r -= up * I_GU; const int e = r / 256, q = r % 256, kb = q / 16, nb = q % 16, n0 = nb * 32;
            const int drow = (n0 >> 7) * 256 + up * 128 + (n0 & 127);
            p0_tr_item(F.in[26 + up] + (size_t)e * DM * DE, DE, kb * 64, n0, F.in[21], 1.0f, WguT + (size_t)e * 1024 * 1024, DM, drow, scr, lane); continue; } r -= 2 * I_GU;
        { const int e = r / 256, q = r % 256, kb = q / 32, nb = q % 32;
            p0_tr_item(F.in[28] + (size_t)e * DE * DM, DM, kb * 64, nb * 32, nullptr, 1.0f, WdT + (size_t)e * 1024 * 512, DE, nb * 32, scr, lane); }
    }
    bf16* XB = (bf16*)(ws + WS_XB); float* rstd1 = (float*)(ws + WS_RSTD1); bf16* MEMN = (bf16*)(ws + WS_MEMN);
    for (int m = gw; m < T + MT; m += NGW) {
        const bool isx = m < T; const int row = isx ? m : m - T;
        const f32x4* xr = (const f32x4*)((isx ? F.in[0] : F.in[1]) + (size_t)row * DM) + lane;
        f32x4 v[4]; float s = 0.f;
#pragma unroll
        for (int j = 0; j < 4; ++j) { v[j] = xr[64 * j]; s += (v[j].x * v[j].x + v[j].y * v[j].y) + (v[j].z * v[j].z + v[j].w * v[j].w); }
        const float rstd = 1.0f / sqrtf(wave_sum(s) * (1.0f / DM) + EPS);
        unsigned long long* o8 = (unsigned long long*)((isx ? XB : MEMN) + (size_t)row * DM) + lane;
        if (isx) { if (lane == 0) rstd1[row] = rstd;
#pragma unroll
            for (int j = 0; j < 4; ++j) o8[64 * j] = (unsigned long long)pk2(v[j].x, v[j].y) | ((unsigned long long)pk2(v[j].z, v[j].w) << 32);
        } else { const f32x4* wv = (const f32x4*)F.in[16] + lane;
#pragma unroll
            for (int j = 0; j < 4; ++j) { const f32x4 w = wv[64 * j]; o8[64 * j] = (unsigned long long)pk2(v[j].x * rstd * w.x, v[j].y * rstd * w.y) | ((unsigned long long)pk2(v[j].z * rstd * w.z, v[j].w * rstd * w.w) << 32); }
        }
    }
    bf16* WrT = (bf16*)(ws + WS_WR);
    for (int i = (F.vcu * NTHR + F.tid); i < 64 * DM; i += F.G * NTHR) {
        const int n = i / DM, k = i % DM; float v = 0.f;
        if (n < 4) v = F.in[22][k * 4 + n]; else if (n < 36) { const int gg = (n - 4) >> 3, e = (n - 4) & 7; v = F.in[24][((size_t)gg * DM + k) * 8 + e]; }
        WrT[i] = (bf16)f2bf(v * F.in[21][k]);
    }
}

struct RsNone { __device__ __forceinline__ float operator()(int) const { return 1.0f; } };
struct RsArr { const float* p; __device__ __forceinline__ float operator()(int r) const { return p[r]; } };
struct RsPart16 { const float* p; __device__ __forceinline__ float operator()(int r) const { const f32x4* q = (const f32x4*)(p + (size_t)r * 16); const f32x4 a = q[0], b = q[1], c = q[2], d = q[3];
    const float s = ((a.x + a.y) + (a.z + a.w)) + ((b.x + b.y) + (b.z + b.w)) + ((c.x + c.y) + (c.z + c.w)) + ((d.x + d.y) + (d.z + d.w)); return 1.0f / sqrtf(s * (1.0f / DM) + EPS); } };

template <class RS> struct EpiBf16 {
    static constexpr bool PERM = true;
    bf16* O; int ldc; RS rs;
    __device__ __forceinline__ bool operator()(f32x4 (&acc)[2][2][4][2], const pg8::Unit& u, int wr, int wc, int fr, int fq) const {
        const int row0 = u.pm * 256 + wr * 64 + fr, col0 = u.pn * 256 + wc * 32 + 8 * fq;
#pragma unroll
        for (int ai = 0; ai < 2; ++ai)
#pragma unroll
            for (int m = 0; m < 4; ++m) { const int row = row0 + ai * 128 + m * 16; const float s = rs(row); bf16* rowp = O + (size_t)row * ldc + col0;
#pragma unroll
                for (int bj = 0; bj < 2; ++bj) { const f32x4 v0 = acc[ai][bj][m][0] * s, v1 = acc[ai][bj][m][1] * s; u32x4 w;
                    w.x = pg8::cvt_pk_bf16(v0[0], v0[1]); w.y = pg8::cvt_pk_bf16(v0[2], v0[3]); w.z = pg8::cvt_pk_bf16(v1[0], v1[1]); w.w = pg8::cvt_pk_bf16(v1[2], v1[3]);
                    *(u32x4*)(rowp + bj * 128) = w; } }
        return false;
    }
};

template <bool MIX> struct EpiRes {
    static constexpr bool PERM = false;
    const float* res; float* xo; bf16* xb; float* ssq;
    const LAS float* stab;
    __device__ __forceinline__ bool operator()(f32x4 (&acc)[2][2][4][2], const pg8::Unit& u, int wr, int wc, int fr, int fq) const {
        const int rt0 = wr * 64 + fr, row0 = u.pm * 256 + rt0, col0 = u.pn * 256 + wc * 32 + 4 * fq;
        const LAS float* st = stab + ((u.idx >> 1) & 3) * 512;
        if (MIX && u.aux == 0) {
#pragma unroll
            for (int ai = 0; ai < 2; ++ai)
#pragma unroll
                for (int m = 0; m < 4; ++m) { const float q = st[(rt0 + ai * 128 + m * 16) * 2];
#pragma unroll
                    for (int bj = 0; bj < 2; ++bj)
#pragma unroll
                        for (int n = 0; n < 2; ++n) acc[ai][bj][m][n] = acc[ai][bj][m][n] * q; }
            return true;
        }
#pragma unroll
        for (int ai = 0; ai < 2; ++ai)
#pragma unroll
            for (int m = 0; m < 4; ++m) { const int row = row0 + ai * 128 + m * 16; float s = 1.0f;
                if (MIX) s = st[(rt0 + ai * 128 + m * 16) * 2 + 1];
                const size_t off = (size_t)row * DM + col0; float q = 0.f;
#pragma unroll
                for (int bj = 0; bj < 2; ++bj)
#pragma unroll
                    for (int n = 0; n < 2; ++n) { const f32x4 r4 = *(const f32x4*)(res + off + bj * 128 + n * 16); const f32x4 v = r4 + acc[ai][bj][m][n] * s;
                        *(f32x4*)(xo + off + bj * 128 + n * 16) = v; u32x2 w; w.x = pg8::cvt_pk_bf16(v[0], v[1]); w.y = pg8::cvt_pk_bf16(v[2], v[3]);
                        *(u32x2*)(xb + off + bj * 128 + n * 16) = w; q += (v[0] * v[0] + v[1] * v[1]) + (v[2] * v[2] + v[3] * v[3]); }
                q += __shfl_xor(q, 16); q += __shfl_xor(q, 32);
                if (fq == 0) ssq[(size_t)row * 16 + u.pn * 4 + wc] = q; }
        return false;
    }
};
__device__ __forceinline__ void p3_scale_table(Frame& F, const pg8::StaticOrder& S, LAS float* stab) {
    const float* ssqr = (const float*)(F.ws + WS_SSQR); const float* ssqa = (const float*)(F.ws + WS_SSQA);
    pg8::Unit u;
    for (int i = 0; i < 4 && S.next(i, u); ++i) {
        if (F.tid < 256) { const int row = u.pm * 256 + F.tid; float sr = 0.f, sa = 0.f;
#pragma unroll 8
            for (int j = 0; j < 32; ++j) sr += ssqr[(size_t)j * T + row];
#pragma unroll
            for (int j = 0; j < 8; ++j) sa += ssqa[(size_t)j * T + row];
            const float rr = 1.0f / sqrtf(sr * (1.0f / DRNN) + EPS), ra = 1.0f / sqrtf(sa * (1.0f / DATT) + EPS);
            stab[(i * 256 + F.tid) * 2] = rr / ra; stab[(i * 256 + F.tid) * 2 + 1] = ra; }
    }
    __syncthreads();
}

struct MoeTab { int mt_pref[NE + 1]; };
struct MoeOrder {
    const LAS int* pref;
    int G, c, ntile;
    __device__ __forceinline__ bool next(int i, pg8::Unit& u) const {
        const int L = i * G + c; if (L >= ntile * 4) return false;
        const int tl = L >> 2; u.pn = L & 3;
        int e = 0;
#pragma unroll
        for (int j = 1; j < NE; ++j) e += (pref[j] <= tl) ? 1 : 0;
        u.aux = e; u.pm = tl; u.idx = i; return true;
    }
};
struct GatherG {
    const bf16* A; const bf16* Bt; int lda, ldb, nt;
    static constexpr bool GATHER = true;
    __device__ __forceinline__ const char* a_base(const pg8::Unit&) const { return (const char*)A; }
    __device__ __forceinline__ const char* b_base(const pg8::Unit& u) const { return (const char*)(Bt + ((size_t)u.aux * 1024 + (size_t)u.pn * 256) * ldb); }
    __device__ __forceinline__ void a_voff(const pg8::Unit& u, const int (&R)[2], const int (&C)[2], unsigned (&v)[2][2], const LAS int* ltok) const {
#pragma unroll
        for (int h = 0; h < 2; ++h)
#pragma unroll
            for (int i = 0; i < 2; ++i) { const int tok = ltok[(u.idx & 7) * 256 + h * 128 + R[i]] >> 1; v[h][i] = (unsigned)(tok * lda + C[i]) * 2u; }
    }
};
struct DownG {
    const bf16* A; const bf16* Bt; int lda, ldb, nt;
    static constexpr bool GATHER = false;
    __device__ __forceinline__ const char* a_base(const pg8::Unit& u) const { return (const char*)(A + (size_t)u.pm * 256 * lda); }
    __device__ __forceinline__ const char* b_base(const pg8::Unit& u) const { return (const char*)(Bt + ((size_t)u.aux * 1024 + (size_t)u.pn * 256) * ldb); }
    __device__ __forceinline__ void a_voff(const pg8::Unit&, const int (&R)[2], const int (&C)[2], unsigned (&v)[2][2], const LAS int*) const {
#pragma unroll
        for (int h = 0; h < 2; ++h)
#pragma unroll
            for (int i = 0; i < 2; ++i) v[h][i] = (unsigned)((h * 128 + R[i]) * lda + C[i]) * 2u;
    }
};
struct EpiGateUp {
    static constexpr bool PERM = true;
    bf16* H; const LAS int* ltok; RsPart16 rs;
    __device__ __forceinline__ bool operator()(f32x4 (&acc)[2][2][4][2], const pg8::Unit& u, int wr, int wc, int fr, int fq) const {
        const int rt0 = wr * 64 + fr, row0 = u.pm * 256 + rt0, col0 = u.pn * 128 + wc * 32 + 8 * fq;
#pragma unroll
        for (int ai = 0; ai < 2; ++ai)
#pragma unroll
            for (int m = 0; m < 4; ++m) { bf16* rowp = H + (size_t)(row0 + ai * 128 + m * 16) * DE + col0; float h[8];
                int sl = ltok[(u.idx & 7) * 256 + rt0 + ai * 128 + m * 16]; sl = sl < 0 ? 0 : sl; const float rstd = rs(sl >> 1);
#pragma unroll
                for (int n = 0; n < 2; ++n)
#pragma unroll
                    for (int j = 0; j < 4; ++j) { const float gv = acc[ai][0][m][n][j] * rstd, uv = acc[ai][1][m][n][j] * rstd; h[n * 4 + j] = gv / (1.0f + __expf(-gv)) * uv; }
                u32x4 w; w.x = pg8::cvt_pk_bf16(h[0], h[1]); w.y = pg8::cvt_pk_bf16(h[2], h[3]); w.z = pg8::cvt_pk_bf16(h[4], h[5]); w.w = pg8::cvt_pk_bf16(h[6], h[7]);
                *(u32x4*)rowp = w; }
        return false;
    }
};
struct EpiDown {
    static constexpr bool PERM = true;
    bf16* Y; const float* slotw; const LAS int* ltok;
    __device__ __forceinline__ bool operator()(f32x4 (&acc)[2][2][4][2], const pg8::Unit& u, int wr, int wc, int fr, int fq) const {
        const int col0 = u.pn * 256 + wc * 32 + 8 * fq;
#pragma unroll
        for (int ai = 0; ai < 2; ++ai)
#pragma unroll
            for (int m = 0; m < 4; ++m) { const int slot = ltok[(u.idx & 7) * 256 + ai * 128 + wr * 64 + m * 16 + fr];
                if (slot >= 0) { const float s = slotw[slot]; bf16* rowp = Y + (size_t)slot * DM + col0;
#pragma unroll
                    for (int bj = 0; bj < 2; ++bj) { const f32x4 v0 = acc[ai][bj][m][0] * s, v1 = acc[ai][bj][m][1] * s; u32x4 w;
                        w.x = pg8::cvt_pk_bf16(v0[0], v0[1]); w.y = pg8::cvt_pk_bf16(v0[2], v0[3]); w.z = pg8::cvt_pk_bf16(v1[0], v1[1]); w.w = pg8::cvt_pk_bf16(v1[2], v1[3]);
                        *(u32x4*)(rowp + bj * 128) = w; } } }
        return false;
    }
};

__device__ __forceinline__ float sigmoidf_(float x) { return 1.0f / (1.0f + __expf(-x)); }
__device__ __forceinline__ float gelu_tanh(float x) { const float u = 0.7978845608028654f * (x + 0.044715f * x * x * x); return 0.5f * x * (1.0f + tanhf(u)); }

constexpr int RT = 256;
constexpr int R_XCB = 0;
constexpr int R_XCF = 36864;
constexpr int R_AF = R_XCF + 16 * 260 * 4;
constexpr int R_UF = R_AF + 16 * 260 * 4;
constexpr int R_SA = R_UF + 16 * 260 * 4;
constexpr int R_SH = R_SA + 2048;
constexpr int R_CARRY = R_SH + 2048;
__device__ __forceinline__ void rnn_item(Frame& F, int item) {
    const int b = item >> 5, cb = (item >> 2) & 7, sl = item & 3;
    const int tid = F.tid, lane = F.lane, wave = F.wave;
    LAS unsigned char* lds = F.lds;
    const bf16* proj = (const bf16*)(F.ws + WS_PROJ);
    bf16* ymix = (bf16*)(F.ws + WS_YMIX); float* ssqr = (float*)(F.ws + WS_SSQR);
    const float* conv_w = F.in[4]; const float* conv_b = F.in[5];
    const int g = tid & 7; const int chn0 = cb * 64 + g * 8;
    float cw[4][8], cbv[8];
#pragma unroll
    for (int j = 0; j < 4; ++j)
#pragma unroll
        for (int i = 0; i < 8; ++i) cw[j][i] = conv_w[j * DRNN + chn0 + i];
#pragma unroll
    for (int i = 0; i < 8; ++i) cbv[i] = conv_b[chn0 + i];
    const int d = lane & 15, q4 = lane >> 4;
    bf16x8 bwa[2], bwx[2];
    {
        const float* wa = F.in[6] + (size_t)cb * 64 * 64 + sl * 16 + d; const float* wx = F.in[8] + (size_t)cb * 64 * 64 + sl * 16 + d;
#pragma unroll
        for (int ks = 0; ks < 2; ++ks)
#pragma unroll
            for (int j = 0; j < 8; ++j) { const int k = 32 * ks + 8 * q4 + j; bwa[ks][j] = (short)f2bf(wa[k * 64]); bwx[ks][j] = (short)f2bf(wx[k * 64]); }
    }
    const int chd = cb * 64 + sl * 16 + d;
    const float ba = F.in[7][chd], bx = F.in[9][chd];
    const float lam = F.in[10][chd];
    const float spc = -8.0f * log1pf(__expf(-lam));
    const int sch = tid & 15, seg = tid >> 4;
    LAS float* xcf = (LAS float*)(lds + R_XCF); LAS float* af = (LAS float*)(lds + R_AF); LAS float* uf = (LAS float*)(lds + R_UF);
    LAS float* sA = (LAS float*)(lds + R_SA); LAS float* sH = (LAS float*)(lds + R_SH); LAS float* carry = (LAS float*)(lds + R_CARRY);
    if (tid < 16) carry[tid] = 0.f;
    __syncthreads();
    for (int tile = 0; tile < SEQ / RT; ++tile) {
        const int t0 = tile * RT;
#pragma unroll
        for (int k = 0; k < 4; ++k) {
            const int tt = (tid >> 3) + 64 * k; const int tg = t0 + tt;
            float xc[8];
#pragma unroll
            for (int i = 0; i < 8; ++i) xc[i] = cbv[i];
#pragma unroll
            for (int j = 0; j < 4; ++j) { const int ts = tg - 3 + j;
                if (ts >= 0) { const u32x4 w = *(const u32x4*)(proj + (size_t)(b * SEQ + ts) * DIN + chn0);
                    xc[0] += cw[j][0] * bflo(w.x); xc[1] += cw[j][1] * bfhi(w.x); xc[2] += cw[j][2] * bflo(w.y); xc[3] += cw[j][3] * bfhi(w.y);
                    xc[4] += cw[j][4] * bflo(w.z); xc[5] += cw[j][5] * bfhi(w.z); xc[6] += cw[j][6] * bflo(w.w); xc[7] += cw[j][7] * bfhi(w.w); } }
            u32x4 o; o.x = pk2(xc[0], xc[1]); o.y = pk2(xc[2], xc[3]); o.z = pk2(xc[4], xc[5]); o.w = pk2(xc[6], xc[7]);
            *(LAS u32x4*)(lds + R_XCB + tt * 144 + g * 16) = o;
            if ((g >> 1) == sl) {
#pragma unroll
                for (int i = 0; i < 8; ++i) xcf[((g & 1) * 8 + i) * 260 + tt] = xc[i]; }
        }
        __syncthreads();
#pragma unroll
        for (int rt = 0; rt < 2; ++rt) {
            const int tb = 32 * wave + 16 * rt;
            f32x4 cr = {0.f, 0.f, 0.f, 0.f}, ci = {0.f, 0.f, 0.f, 0.f};
#pragma unroll
            for (int ks = 0; ks < 2; ++ks) { const bf16x8 a = *(const LAS bf16x8*)(lds + R_XCB + (tb + d) * 144 + (32 * ks + 8 * q4) * 2);
                cr = __builtin_amdgcn_mfma_f32_16x16x32_bf16(a, bwa[ks], cr, 0, 0, 0); ci = __builtin_amdgcn_mfma_f32_16x16x32_bf16(a, bwx[ks], ci, 0, 0, 0); }
            const int tk = tb + 4 * q4;
            const f32x4 xv = *(const LAS f32x4*)(xcf + d * 260 + tk);
            f32x4 av, uv;
#pragma unroll
            for (int j = 0; j < 4; ++j) { const float r = sigmoidf_(cr[j] + ba), ig = sigmoidf_(ci[j] + bx); const float la = spc * r; const float a = __expf(la);
                av[j] = a; uv[j] = sqrtf(fmaxf(-expm1f(2.0f * la), 0.f)) * (ig * xv[j]); }
            *(LAS f32x4*)(af + d * 260 + tk) = av; *(LAS f32x4*)(uf + d * 260 + tk) = uv;
        }
        __syncthreads();
        float a8[8], u8[8];
        {
            const f32x4 a0 = *(const LAS f32x4*)(af + sch * 260 + seg * 8), a1 = *(const LAS f32x4*)(af + sch * 260 + seg * 8 + 4);
            const f32x4 u0 = *(const LAS f32x4*)(uf + sch * 260 + seg * 8), u1 = *(const LAS f32x4*)(uf + sch * 260 + seg * 8 + 4);
#pragma unroll
            for (int j = 0; j < 4; ++j) { a8[j] = a0[j]; a8[4 + j] = a1[j]; u8[j] = u0[j]; u8[4 + j] = u1[j]; }
        }
        float A = 1.f, H = 0.f;
#pragma unroll
        for (int j = 0; j < 8; ++j) { H = a8[j] * H + u8[j]; A *= a8[j]; }
        sA[seg * 16 + sch] = A; sH[seg * 16 + sch] = H;
        __syncthreads();
        float h = carry[sch];
        for (int s = 0; s < seg; ++s) h = sA[s * 16 + sch] * h + sH[s * 16 + sch];
#pragma unroll
        for (int j = 0; j < 8; ++j) {
            h = a8[j] * h + u8[j];
            const int tg = t0 + seg * 8 + j; const size_t row = (size_t)b * SEQ + tg;
            const float xg = bf2f(proj[row * DIN + DRNN + cb * 64 + sl * 16 + sch]);
            const float y = gelu_tanh(xg) * h;
            ymix[row * DM + cb * 64 + sl * 16 + sch] = (bf16)f2bf(y);
            float s2 = y * y;
            s2 += __shfl_xor(s2, 1); s2 += __shfl_xor(s2, 2); s2 += __shfl_xor(s2, 4); s2 += __shfl_xor(s2, 8);
            if (sch == 0) ssqr[(size_t)(cb * 4 + sl) * T + row] = s2;
        }
        __syncthreads();
        if (seg == 31) carry[sch] = h;
    }
    __syncthreads();
}

constexpr int A_VT = 0;
constexpr int A_BIAS = 8 * 9216;
__device__ __forceinline__ void attn_item(Frame& F, int item) {
    const int b = item & 7, c = item >> 3;
    const int lane = F.lane, h = F.wave, r32 = lane & 31, hi = lane >> 5;
    const bf16* proj = (const bf16*)(F.ws + WS_PROJ);
    bf16* ymix = (bf16*)(F.ws + WS_YMIX); float* ssqa = (float*)(F.ws + WS_SSQA);
    LAS unsigned char* vt = F.lds + A_VT + h * 9216;
    LAS float* bl = (LAS float*)(F.lds + A_BIAS + h * 1040);
    for (int i = lane; i < 257; i += 64) bl[i] = F.in[11][h * 257 + i];
    const size_t qrow0 = (size_t)b * SEQ + c * CHUNK;
    const bf16* qptr = proj + (qrow0 + r32) * DIN + 1024 + h * HD + hi * 8;
    f32x16 o[2][2];
#pragma unroll
    for (int i = 0; i < 2; ++i)
#pragma unroll
        for (int j = 0; j < 2; ++j)
#pragma unroll
            for (int r = 0; r < 16; ++r) o[i][j][r] = 0.f;
    float mrun[2] = {-1e30f, -1e30f}, lrun[2] = {0.f, 0.f};
    const float bfar = F.in[11][h * 257 + 256];
    LDS_WAIT();
    const int jc0 = c - LEFT > 0 ? c - LEFT : 0;
    for (int jc = jc0; jc <= c; ++jc) {
        const size_t krow0 = (size_t)b * SEQ + jc * CHUNK;
#pragma unroll
        for (int p = 0; p < 8; ++p) { const int key = p * 8 + (lane >> 3), ch = lane & 7;
            const u32x4 v = *(const u32x4*)(proj + (krow0 + key) * DIN + 2048 + h * HD + ch * 8);
            *(LAS u32x4*)(vt + key * 144 + ch * 16) = v; if (p == 3) asm volatile("" ::: "memory"); }
        asm volatile("" ::: "memory");
        f32x16 s[2][2];
#pragma unroll
        for (int kb = 0; kb < 2; ++kb) {
            bf16x8 kf[4];
#pragma unroll
            for (int ks = 0; ks < 4; ++ks) kf[ks] = *(const bf16x8*)(proj + (krow0 + kb * 32 + r32) * DIN + 1536 + h * HD + ks * 16 + hi * 8);
#pragma unroll
            for (int qb = 0; qb < 2; ++qb) { f32x16 z;
#pragma unroll
                for (int r = 0; r < 16; ++r) z[r] = 0.f;
#pragma unroll
                for (int ks = 0; ks < 4; ++ks) { const bf16x8 qf = *(const bf16x8*)(qptr + (size_t)qb * 32 * DIN + ks * 16); z = __builtin_amdgcn_mfma_f32_32x32x16_bf16(kf[ks], qf, z, 0, 0, 0); }
                s[kb][qb] = z; }
            asm volatile("" ::: "memory");
        }
        const int dc = c - jc;
        if (dc >= 3) {
#pragma unroll
            for (int kb = 0; kb < 2; ++kb)
#pragma unroll
                for (int qb = 0; qb < 2; ++qb)
#pragma unroll
                    for (int r = 0; r < 16; ++r) s[kb][qb][r] += bfar;
        } else {
#pragma unroll
            for (int kb = 0; kb < 2; ++kb)
#pragma unroll
                for (int qb = 0; qb < 2; ++qb)
#pragma unroll
                for (int r = 0; r < 16; ++r) { if (r == 0) asm volatile("" ::: "memory"); const int kk = kb * 32 + (r & 3) + 8 * (r >> 2) + 4 * hi; int dist = dc * 64 + qb * 32 + r32 - kk; dist = dist > 128 ? 128 : dist;
                        s[kb][qb][r] += bl[dist + 128]; }
        }
        LDS_WAIT();
#pragma unroll
        for (int qb = 0; qb < 2; ++qb) {
            float mx = s[0][qb][0];
#pragma unroll
            for (int r = 0; r < 16; ++r) { mx = fmaxf(mx, s[0][qb][r]); mx = fmaxf(mx, s[1][qb][r]); }
            mx = fmaxf(mx, __shfl_xor(mx, 32));
            const float mn = fmaxf(mrun[qb], mx); const float alpha = __expf(mrun[qb] - mn); mrun[qb] = mn;
            float sum = 0.f;
#pragma unroll
            for (int kb = 0; kb < 2; ++kb)
#pragma unroll
                for (int r = 0; r < 16; ++r) { const float p = __expf(s[kb][qb][r] - mn); s[kb][qb][r] = p; sum += p; }
            lrun[qb] = lrun[qb] * alpha + sum;
#pragma unroll
            for (int db = 0; db < 2; ++db)
#pragma unroll
                for (int r = 0; r < 16; ++r) o[db][qb][r] *= alpha;
        }
#pragma unroll
        for (int kb = 0; kb < 2; ++kb)
#pragma unroll
            for (int s2 = 0; s2 < 2; ++s2) {
                bf16x8 pf[2];
#pragma unroll
                for (int qb = 0; qb < 2; ++qb) { u32x4 w;
                    w.x = pg8::cvt_pk_bf16(s[kb][qb][8 * s2 + 0], s[kb][qb][8 * s2 + 1]); w.y = pg8::cvt_pk_bf16(s[kb][qb][8 * s2 + 2], s[kb][qb][8 * s2 + 3]);
                    w.z = pg8::cvt_pk_bf16(s[kb][qb][8 * s2 + 4], s[kb][qb][8 * s2 + 5]); w.w = pg8::cvt_pk_bf16(s[kb][qb][8 * s2 + 6], s[kb][qb][8 * s2 + 7]);
                    pf[qb] = __builtin_bit_cast(bf16x8, w); }
#pragma unroll
                for (int db = 0; db < 2; ++db) {
                    const int key0 = 32 * kb + 16 * s2 + 4 * hi, li = lane & 15, dg = (lane >> 4) & 1;
                    const LAS unsigned char* p0 = vt + (key0 + (li >> 2)) * 144 + (32 * db + 16 * dg + 4 * (li & 3)) * 2;
                    const s16x4 v0 = __builtin_bit_cast(s16x4, __builtin_amdgcn_ds_read_tr16_b64_v4i16((LAS s16x4*)p0));
                    const s16x4 v1 = __builtin_bit_cast(s16x4, __builtin_amdgcn_ds_read_tr16_b64_v4i16((LAS s16x4*)(p0 + 8 * 144)));
                    const bf16x8 vf = (bf16x8){v0[0], v0[1], v0[2], v0[3], v1[0], v1[1], v1[2], v1[3]};
#pragma unroll
                    for (int qb = 0; qb < 2; ++qb) o[db][qb] = __builtin_amdgcn_mfma_f32_32x32x16_bf16(vf, pf[qb], o[db][qb], 0, 0, 0);
                }
            }
        LDS_WAIT();
    }
#pragma unroll
    for (int qb = 0; qb < 2; ++qb) {
        const float l = lrun[qb] + __shfl_xor(lrun[qb], 32); const float il = 1.0f / l;
        const size_t row = qrow0 + qb * 32 + r32; float s2 = 0.f;
#pragma unroll
        for (int db = 0; db < 2; ++db)
#pragma unroll
            for (int g4 = 0; g4 < 4; ++g4) { const float v0 = o[db][qb][4 * g4 + 0] * il, v1 = o[db][qb][4 * g4 + 1] * il, v2 = o[db][qb][4 * g4 + 2] * il, v3 = o[db][qb][4 * g4 + 3] * il;
                s2 += (v0 * v0 + v1 * v1) + (v2 * v2 + v3 * v3);
                u32x2 w; w.x = pg8::cvt_pk_bf16(v0, v1); w.y = pg8::cvt_pk_bf16(v2, v3);
                *(u32x2*)(ymix + row * DM + DRNN + h * HD + db * 32 + 8 * g4 + 4 * hi) = w; }
        s2 += __shfl_xor(s2, 32);
        if (hi == 0) ssqa[(size_t)h * T + row] = s2;
    }
}
__device__ __forceinline__ void p2_mixers(Frame& F) {
    for (int it = blockIdx.x; it < 256; it += F.G) rnn_item(F, it);
    for (int it = blockIdx.x; it < BATCH * NCHUNK; it += F.G) { attn_item(F, it); __syncthreads(); }
}

constexpr int X_VT = 0;
__device__ __forceinline__ void xattn_item(Frame& F, int item) {
    const int b = item & 7, hd = (item >> 3) & 3, qt = item >> 5;
    const int lane = F.lane, wave = F.wave, tid = F.tid, r32 = lane & 31, hi = lane >> 5;
    const bf16* qx = (const bf16*)(F.ws + WS_QX); const bf16* kv = (const bf16*)(F.ws + WS_KV); bf16* O = (bf16*)(F.ws + WS_O);
    LAS unsigned char* vt = F.lds + X_VT;
    const size_t qrow = (size_t)b * SEQ + qt * 256 + wave * 32 + r32;
    const bf16* qp = qx + qrow * DM + hd * XD + hi * 8;
    const bf16* kp = kv + ((size_t)b * NMEM + r32) * 2048 + hd * XD + hi * 8;
    f32x16 s[8];
#pragma unroll
    for (int kb = 0; kb < 8; ++kb)
#pragma unroll
        for (int r = 0; r < 16; ++r) s[kb][r] = 0.f;
#pragma unroll 2
    for (int ks = 0; ks < 16; ++ks) {
        const bf16x8 qf = *(const bf16x8*)(qp + ks * 16);
#pragma unroll
        for (int kb = 0; kb < 8; ++kb) { const bf16x8 kf = *(const bf16x8*)(kp + (size_t)kb * 32 * 2048 + ks * 16);
            s[kb] = __builtin_amdgcn_mfma_f32_32x32x16_bf16(kf, qf, s[kb], 0, 0, 0); }
    }
    float mx = s[0][0];
#pragma unroll
    for (int kb = 0; kb < 8; ++kb)
#pragma unroll
        for (int r = 0; r < 16; ++r) mx = fmaxf(mx, s[kb][r]);
    mx = fmaxf(mx, __shfl_xor(mx, 32));
    float sum = 0.f;
    bf16x8 pf[8][2];
#pragma unroll
    for (int kb = 0; kb < 8; ++kb) {
#pragma unroll
        for (int r = 0; r < 16; ++r) { const float p = __expf(s[kb][r] - mx); s[kb][r] = p; sum += p; }
#pragma unroll
        for (int s2 = 0; s2 < 2; ++s2) { u32x4 w;
            w.x = pg8::cvt_pk_bf16(s[kb][8 * s2 + 0], s[kb][8 * s2 + 1]); w.y = pg8::cvt_pk_bf16(s[kb][8 * s2 + 2], s[kb][8 * s2 + 3]);
            w.z = pg8::cvt_pk_bf16(s[kb][8 * s2 + 4], s[kb][8 * s2 + 5]); w.w = pg8::cvt_pk_bf16(s[kb][8 * s2 + 6], s[kb][8 * s2 + 7]);
            pf[kb][s2] = __builtin_bit_cast(bf16x8, w); }
    }
    sum += __shfl_xor(sum, 32);
    const float il = 1.0f / sum;
    f32x16 o[8];
#pragma unroll
    for (int db = 0; db < 8; ++db)
#pragma unroll
        for (int r = 0; r < 16; ++r) o[db][r] = 0.f;
#pragma unroll
    for (int kt = 0; kt < 4; ++kt) {
        __syncthreads();
#pragma unroll
        for (int p = 0; p < 4; ++p) { const int key = p * 16 + (tid >> 5), ch = tid & 31;
            const u32x4 v = *(const u32x4*)(kv + ((size_t)b * NMEM + kt * 64 + key) * 2048 + 1024 + hd * XD + ch * 8);
            *(LAS u32x4*)(vt + key * 528 + ch * 16) = v; }
        __syncthreads();
#pragma unroll
        for (int kb2 = 0; kb2 < 2; ++kb2)
#pragma unroll
            for (int s2 = 0; s2 < 2; ++s2) {
                const int key0 = 32 * kb2 + 16 * s2 + 4 * hi, li = lane & 15, dg = (lane >> 4) & 1;
                const LAS unsigned char* pb = vt + (key0 + (li >> 2)) * 528 + (16 * dg + 4 * (li & 3)) * 2;
#pragma unroll
                for (int db = 0; db < 8; ++db) {
                    const s16x4 v0 = __builtin_bit_cast(s16x4, __builtin_amdgcn_ds_read_tr16_b64_v4i16((LAS s16x4*)(pb + db * 64)));
                    const s16x4 v1 = __builtin_bit_cast(s16x4, __builtin_amdgcn_ds_read_tr16_b64_v4i16((LAS s16x4*)(pb + db * 64 + 8 * 528)));
                    const bf16x8 vf = (bf16x8){v0[0], v0[1], v0[2], v0[3], v1[0], v1[1], v1[2], v1[3]};
                    o[db] = __builtin_amdgcn_mfma_f32_32x32x16_bf16(vf, pf[kt * 2 + kb2][s2], o[db], 0, 0, 0);
                }
            }
    }
    bf16* op = O + qrow * DM + hd * XD + 4 * hi;
#pragma unroll
    for (int db = 0; db < 8; ++db)
#pragma unroll
        for (int g4 = 0; g4 < 4; ++g4) { u32x2 w; w.x = pg8::cvt_pk_bf16(o[db][4 * g4 + 0] * il, o[db][4 * g4 + 1] * il); w.y = pg8::cvt_pk_bf16(o[db][4 * g4 + 2] * il, o[db][4 * g4 + 3] * il);
            *(u32x2*)(op + db * 32 + 8 * g4) = w; }
}

constexpr int RL_LOG = 0;
constexpr int RL_CNT = 8 * 32 * 40 * 4;
__device__ __forceinline__ void p7_router(Frame& F) {
    const int lane = F.lane, wave = F.wave, tid = F.tid, r32 = lane & 31, hi = lane >> 5;
    const bf16* xb = (const bf16*)(F.ws + WS_XB); const bf16* WrT = (const bf16*)(F.ws + WS_WR);
    const float* ssq2 = (const float*)(F.ws + WS_SSQ2);
    float* slotw = (float*)(F.ws + WS_SLOTW); int* list = (int*)(F.ws + WS_LIST);
    unsigned* gcnt = (unsigned*)(F.ws + WS_CTL) + CW_CNT;
    LAS float* lg = (LAS float*)(F.lds + RL_LOG) + wave * 32 * 40;
    LAS int* lcnt = (LAS int*)(F.lds + RL_CNT); LAS int* lbase = lcnt + 32;
    for (int blk = blockIdx.x; blk < T / 256; blk += F.G) {
        const int tok0 = blk * 256 + wave * 32;
        if (tid < 32) lcnt[tid] = 0;
        __syncthreads();
        f32x16 c0, c1;
#pragma unroll
        for (int r = 0; r < 16; ++r) { c0[r] = 0.f; c1[r] = 0.f; }
        const bf16* ap = xb + (size_t)(tok0 + r32) * DM + hi * 8; const bf16* bp = WrT + (size_t)r32 * DM + hi * 8;
#pragma unroll 4
        for (int ks = 0; ks < 64; ++ks) { const bf16x8 a = *(const bf16x8*)(ap + ks * 16); const bf16x8 b0 = *(const bf16x8*)(bp + ks * 16), b1 = *(const bf16x8*)(bp + (size_t)32 * DM + ks * 16);
            c0 = __builtin_amdgcn_mfma_f32_32x32x16_bf16(a, b0, c0, 0, 0, 0); c1 = __builtin_amdgcn_mfma_f32_32x32x16_bf16(a, b1, c1, 0, 0, 0); }
#pragma unroll
        for (int r = 0; r < 16; ++r) { const int tk = (r & 3) + 8 * (r >> 2) + 4 * hi; lg[tk * 40 + r32] = c0[r]; if (r32 < 8) lg[tk * 40 + 32 + r32] = c1[r]; }
        LDS_WAIT();
        int e0 = 0, e1 = 0; float w0 = 0.f, w1 = 0.f; int lp0 = 0, lp1 = 0;
        if (lane < 32) {
            const int tok = tok0 + lane; const RsPart16 rsp{ssq2}; const float rstd = rsp(tok);
            float gl[4]; int gi = 0;
#pragma unroll
            for (int j = 0; j < 4; ++j) gl[j] = lg[lane * 40 + j] * rstd + F.in[23][j];
            float gm = gl[0];
#pragma unroll
            for (int j = 1; j < 4; ++j) if (gl[j] > gm) { gm = gl[j]; gi = j; }
            float gs = 0.f;
#pragma unroll
            for (int j = 0; j < 4; ++j) gs += __expf(gl[j] - gm);
            const float gp = 1.0f / gs;
            float el[8];
#pragma unroll
            for (int j = 0; j < 8; ++j) el[j] = lg[lane * 40 + 4 + gi * 8 + j] * rstd + F.in[25][gi * 8 + j];
            int i0 = 0; float m0 = el[0];
#pragma unroll
            for (int j = 1; j < 8; ++j) if (el[j] > m0) { m0 = el[j]; i0 = j; }
            int i1 = -1; float m1 = -3.0e38f;
#pragma unroll
            for (int j = 0; j < 8; ++j) if (j != i0 && el[j] > m1) { m1 = el[j]; i1 = j; }
            const float p1 = __expf(m1 - m0); const float inv = 1.0f / (1.0f + p1);
            e0 = gi * 8 + i0; e1 = gi * 8 + i1; w0 = gp * inv; w1 = gp * p1 * inv;
            lp0 = atomicAdd((int*)&lcnt[e0], 1); lp1 = atomicAdd((int*)&lcnt[e1], 1);
            slotw[2 * tok] = w0; slotw[2 * tok + 1] = w1;
        }
        __syncthreads();
        if (tid < 32) lbase[tid] = (int)atomicAdd(&gcnt[tid], (unsigned)lcnt[tid]);
        __syncthreads();
        if (lane < 32) { const int tok = tok0 + lane;
            list[(size_t)e0 * T + lbase[e0] + lp0] = 2 * tok; list[(size_t)e1 * T + lbase[e1] + lp1] = 2 * tok + 1; }
        __syncthreads();
    }
}

__device__ __forceinline__ int moe_tables(Frame& F, LAS int* pref) {
    const unsigned* gcnt = (const unsigned*)(F.ws + WS_CTL) + CW_CNT;
    if (F.tid == 0) { int acc = 0; for (int e = 0; e < NE; ++e) { pref[e] = acc; acc += ((int)__hip_atomic_load(gcnt + e, RLX_AGENT) + 255) >> 8; } pref[NE] = acc; }
    __syncthreads();
    return pref[NE];
}
__device__ __forceinline__ void moe_fill_tok(Frame& F, const MoeOrder& S, LAS int* ltok, const LAS int* pref) {
    const unsigned* gcnt = (const unsigned*)(F.ws + WS_CTL) + CW_CNT; const int* list = (const int*)(F.ws + WS_LIST);
    pg8::Unit u;
    for (int i = 0; i < 8 && S.next(i, u); ++i) {
        if (F.tid < 256) { const int e = u.aux, r = (u.pm - pref[e]) * 256 + F.tid; const int cnt = (int)__hip_atomic_load(gcnt + e, RLX_AGENT);
            ltok[i * 256 + F.tid] = (r < cnt) ? list[(size_t)e * T + r] : -1; }
    }
    __syncthreads();
}
struct GatherG2 : GatherG {
    __device__ __forceinline__ void a_voff(const pg8::Unit& u, const int (&R)[2], const int (&C)[2], unsigned (&v)[2][2], const LAS int* ltok) const {
#pragma unroll
        for (int h = 0; h < 2; ++h)
#pragma unroll
            for (int i = 0; i < 2; ++i) { int sl = ltok[(u.idx & 7) * 256 + h * 128 + R[i]]; sl = sl < 0 ? 0 : sl; v[h][i] = (unsigned)((sl >> 1) * lda + C[i]) * 2u; }
    }
};

__device__ __forceinline__ void p10_final(Frame& F) {
    const int gw = F.vcu * NWAVES + F.wave, NGW = F.G * NWAVES, lane = F.lane;
    const bf16* Y = (const bf16*)(F.ws + WS_YSLOT); float* out = F.out; const f32x4* fw = (const f32x4*)F.in[29] + lane;
    for (int m = gw; m < T; m += NGW) {
        f32x4* xr = (f32x4*)(out + (size_t)m * DM) + lane;
        const u32x2* y0 = (const u32x2*)(Y + (size_t)(2 * m) * DM) + lane; const u32x2* y1 = (const u32x2*)(Y + (size_t)(2 * m + 1) * DM) + lane;
        f32x4 v[4]; float s = 0.f;
#pragma unroll
        for (int j = 0; j < 4; ++j) { v[j] = xr[64 * j]; const u32x2 a = y0[64 * j], c = y1[64 * j];
            v[j].x += bflo(a.x) + bflo(c.x); v[j].y += bfhi(a.x) + bfhi(c.x); v[j].z += bflo(a.y) + bflo(c.y); v[j].w += bfhi(a.y) + bfhi(c.y);
            s += (v[j].x * v[j].x + v[j].y * v[j].y) + (v[j].z * v[j].z + v[j].w * v[j].w); }
        const float rstd = 1.0f / sqrtf(wave_sum(s) * (1.0f / DM) + EPS);
#pragma unroll
        for (int j = 0; j < 4; ++j) { const f32x4 w = fw[64 * j]; xr[64 * j] = v[j] * rstd * w; }
    }
}

constexpr int N_PHASES = 11;
__global__ void __launch_bounds__(NTHR, 2) hymba_fwd(Args args) {
    extern __shared__ __attribute__((aligned(16))) unsigned char lds_raw[];
    Frame F;
    F.lds = (LAS unsigned char*)lds_raw;
    F.tid = threadIdx.x; F.lane = F.tid & 63; F.wave = __builtin_amdgcn_readfirstlane(F.tid >> 6);
    F.G = gridDim.x; { const int bx = blockIdx.x; F.vcu = (F.G % 8 == 0) ? (bx % 8) * (F.G / 8) + bx / 8 : bx; }
    F.in = args.in; F.ws = args.ws; F.out = args.out;
    unsigned char* ws = args.ws;
    volatile LAS unsigned* MISC = (volatile LAS unsigned*)(F.lds + LDS_MISC);
    LAS int* ltok = (LAS int*)(F.lds + LDS_TOK);
    LAS int* pref = (LAS int*)(F.lds + LDS_MISC + 256);
    if (F.tid < 64) MISC[F.tid] = 0u;
    __syncthreads();
    XcdBarrier bar; bar.bar = (unsigned*)(ws + WS_CTL) + CW_BAR; bar.x = 0; bar.st = nullptr;
    if (MK_N_LAUNCHES == 1) bar = xcd_barrier_post((unsigned*)(ws + WS_CTL) + CW_BAR, MISC + 8);
    const int lo = args.ph_lo, hi = args.ph_hi;
#ifndef PH_MASK
#define PH_MASK 0x7ff
#endif
#define IN(k) (((PH_MASK >> (k)) & 1) && lo <= (k) && (k) < hi)
#define SEAM(k) do { if (IN(k) && IN((k) + 1)) xcd_barrier(bar); } while (0)

    if (IN(0)) { p0_prologue(F); } SEAM(0);
    if (IN(1)) {
        { pg8::DenseG g{(const bf16*)(ws + WS_XB), (const bf16*)(ws + WS_WIN), DM, DM, DM / 64, 0}; pg8::StaticOrder S; S.init(T, DIN, F.G, (int)blockIdx.x);
          EpiBf16<RsArr> E{(bf16*)(ws + WS_PROJ), DIN, RsArr{(const float*)(ws + WS_RSTD1)}};
          pg8::gemm_phase<pg8::DenseG, EpiBf16<RsArr>, pg8::StaticOrder, true>(F.lds, ltok, g, S, E); }
        { pg8::DenseG g{(const bf16*)(ws + WS_MEMN), (const bf16*)(ws + WS_WKV), DM, DM, DM / 64, 0}; pg8::StaticOrder S; S.init(MT, 2048, F.G, (int)blockIdx.x);
          EpiBf16<RsNone> E{(bf16*)(ws + WS_KV), 2048, RsNone{}};
          pg8::gemm_phase<pg8::DenseG, EpiBf16<RsNone>, pg8::StaticOrder, true>(F.lds, ltok, g, S, E); }
    } SEAM(1);
    if (IN(2)) { p2_mixers(F); } SEAM(2);
    if (IN(3)) {
        pg8::DenseG g{(const bf16*)(ws + WS_YMIX), (const bf16*)(ws + WS_WOUT), DM, DM, 8, 512}; pg8::TwoHalfOrder S; S.s.init(T, DM, F.G, (int)blockIdx.x);
        p3_scale_table(F, S.s, (LAS float*)(F.lds + LDS_TOK));
        EpiRes<true> E{F.in[0], (float*)(ws + WS_X1), (bf16*)(ws + WS_XB), (float*)(ws + WS_SSQ1), (const LAS float*)(F.lds + LDS_TOK)};
        pg8::gemm_phase<pg8::DenseG, EpiRes<true>, pg8::TwoHalfOrder, true>(F.lds, ltok, g, S, E);
    } SEAM(3);
    if (IN(4)) {
        pg8::DenseG g{(const bf16*)(ws + WS_XB), (const bf16*)(ws + WS_WQ), DM, DM, DM / 64, 0}; pg8::StaticOrder S; S.init(T, DM, F.G, (int)blockIdx.x);
        EpiBf16<RsPart16> E{(bf16*)(ws + WS_QX), DM, RsPart16{(const float*)(ws + WS_SSQ1)}};
        pg8::gemm_phase<pg8::DenseG, EpiBf16<RsPart16>, pg8::StaticOrder, true>(F.lds, ltok, g, S, E);
    } SEAM(4);
    if (IN(5)) { for (int it = blockIdx.x; it < BATCH * XH * (SEQ / 256); it += F.G) xattn_item(F, it); } SEAM(5);
    if (IN(6)) {
        pg8::DenseG g{(const bf16*)(ws + WS_O), (const bf16*)(ws + WS_WO), DM, DM, DM / 64, 0}; pg8::StaticOrder S; S.init(T, DM, F.G, (int)blockIdx.x);
        EpiRes<false> E{(const float*)(ws + WS_X1), F.out, (bf16*)(ws + WS_XB), (float*)(ws + WS_SSQ2), (const LAS float*)(F.lds + LDS_TOK)};
        pg8::gemm_phase<pg8::DenseG, EpiRes<false>, pg8::StaticOrder, true>(F.lds, ltok, g, S, E);
    } SEAM(6);
    if (IN(7)) { p7_router(F); } SEAM(7);
    if (IN(8)) {
        const int ntile = moe_tables(F, pref);
        MoeOrder S{pref, F.G, (int)blockIdx.x, ntile};
        moe_fill_tok(F, S, ltok, pref);
        GatherG2 g; g.A = (const bf16*)(ws + WS_XB); g.Bt = (const bf16*)(ws + WS_WGU); g.lda = DM; g.ldb = DM; g.nt = DM / 64;
        EpiGateUp E{(bf16*)(ws + WS_HID), ltok, RsPart16{(const float*)(ws + WS_SSQ2)}};
        pg8::gemm_phase<GatherG2, EpiGateUp, MoeOrder, true>(F.lds, ltok, g, S, E);
    } SEAM(8);
    if (IN(9)) {
        const int ntile = moe_tables(F, pref);
        MoeOrder S{pref, F.G, (int)blockIdx.x, ntile};
        moe_fill_tok(F, S, ltok, pref);
        DownG g{(const bf16*)(ws + WS_HID), (const bf16*)(ws + WS_WD), DE, DE, DE / 64};
        EpiDown E{(bf16*)(ws + WS_YSLOT), (const float*)(ws + WS_SLOTW), ltok};
        pg8::gemm_phase<DownG, EpiDown, MoeOrder, true>(F.lds, ltok, g, S, E);
    } SEAM(9);
    if (IN(10)) { p10_final(F); }
#undef IN
#undef SEAM
}

extern "C" void kernel_launch(void* const* d_in, const int* in_sizes, int n_in, void* d_out, int out_size, void* d_ws, size_t ws_size, hipStream_t stream) {
    static int grid = 0;
    if (grid == 0) {
        if (n_in != 30 || in_sizes[0] != T * DM || out_size != T * DM || ws_size < WS_END) {
            fprintf(stderr, "kernel_launch: unexpected shapes: n_in %d in0 %d out %d ws %zu (need %zu)\n", n_in, n_in > 0 ? in_sizes[0] : -1, out_size, ws_size, (size_t)WS_END); grid = -1; return; }
        int dev = 0, cus = 0, per_cu = 0;
        if (hipGetDevice(&dev) != hipSuccess || hipDeviceGetAttribute(&cus, hipDeviceAttributeMultiprocessorCount, dev) != hipSuccess) { grid = -1; return; }
        if (hipFuncSetAttribute((const void*)hymba_fwd, hipFuncAttributeMaxDynamicSharedMemorySize, LDS_BYTES) != hipSuccess) { fprintf(stderr, "kernel_launch: hipFuncSetAttribute failed\n"); grid = -1; return; }
        if (hipOccupancyMaxActiveBlocksPerMultiprocessor(&per_cu, (const void*)hymba_fwd, NTHR, LDS_BYTES) != hipSuccess || per_cu < 1) { fprintf(stderr, "kernel_launch: occupancy query failed (%d)\n", per_cu); (void)hipGetLastError(); grid = -1; return; }
        grid = cus;
    }
    if (grid < 0) return;
    (void)hipMemsetAsync((char*)d_ws + WS_CTL, 0, CTL_ZERO_BYTES, stream);
    Args a{};
    for (int i = 0; i < 30; ++i) a.in[i] = (const float*)d_in[i];
    a.out = (float*)d_out; a.ws = (unsigned char*)d_ws;
    if (MK_N_LAUNCHES == 1) {
        a.ph_lo = 0; a.ph_hi = N_PHASES;
        void* kargs[] = {&a};
        hipError_t e = hipLaunchCooperativeKernel((const void*)hymba_fwd, dim3(grid), dim3(NTHR), kargs, LDS_BYTES, stream);
        if (e != hipSuccess) fprintf(stderr, "cooperative launch failed: %s (grid %d)\n", hipGetErrorString(e), grid);
    } else {
        for (int p = 0; p < N_PHASES; ++p) { a.ph_lo = p; a.ph_hi = p + 1; hipLaunchKernelGGL(hymba_fwd, dim3(grid), dim3(NTHR), LDS_BYTES, stream, a); }
    }
}
```

```cpp
#include <hip/hip_runtime.h>
#include <cstdio>
#include <cstdint>

#ifndef PH_DUP
#define PH_DUP -1
#endif
#ifndef MK_N_LAUNCHES
#define MK_N_LAUNCHES 1
#endif

#define LAS __attribute__((address_space(3)))
#define GAS __attribute__((address_space(1)))
typedef unsigned short bf16;
typedef short bf16x8 __attribute__((ext_vector_type(8)));
typedef short s16x4 __attribute__((ext_vector_type(4)));
typedef float f32x4 __attribute__((ext_vector_type(4)));
typedef float f32x16 __attribute__((ext_vector_type(16)));
typedef unsigned u32x4 __attribute__((ext_vector_type(4)));
typedef unsigned u32x2 __attribute__((ext_vector_type(2)));
typedef GAS unsigned gu32;

constexpr int BATCH = 8, SEQ = 4096, DM = 1024, T = BATCH * SEQ;
constexpr int NMEM = 256, MT = BATCH * NMEM;
constexpr int DRNN = 512, DATT = 512, NH = 8, HD = 64, CHUNK = 64, NCHUNK = SEQ / CHUNK, LEFT = 8;
constexpr int DIN = 2 * DRNN + 3 * DATT;
constexpr int XH = 4, XD = 256;
constexpr int NE = 32, DE = 512, NGRP = 4, EPG = 8;
constexpr float EPS = 1e-6f;
constexpr int NWAVES = 8, NTHR = 512;

constexpr size_t MiB = 1u << 20;
constexpr size_t WS_CTL = 0, CTL_ZERO_BYTES = 1 * MiB;
constexpr size_t WS_RSTD1 = 1 * MiB;
constexpr size_t WS_SSQR = 2 * MiB;
constexpr size_t WS_SSQA = 6 * MiB;
constexpr size_t WS_SSQ1 = 7 * MiB;
constexpr size_t WS_SSQ2 = 9 * MiB;
constexpr size_t WS_SLOTW = 11 * MiB;
constexpr size_t WS_LIST = 12 * MiB;
constexpr size_t WS_WIN = 16 * MiB;
constexpr size_t WS_WKV = 21 * MiB;
constexpr size_t WS_WOUT = 25 * MiB;
constexpr size_t WS_WQ = 27 * MiB;
constexpr size_t WS_WO = 29 * MiB;
constexpr size_t WS_WR = 31 * MiB;
constexpr size_t WS_WGU = 32 * MiB;
constexpr size_t WS_WD = 96 * MiB;
constexpr size_t WS_XB = 128 * MiB;
constexpr size_t WS_PROJ = 192 * MiB;
constexpr size_t WS_X1 = 192 * MiB;
constexpr size_t WS_YSLOT = 192 * MiB;
constexpr size_t WS_HID = 320 * MiB;
constexpr size_t WS_YMIX = 352 * MiB;
constexpr size_t WS_QX = 352 * MiB;
constexpr size_t WS_MEMN = 416 * MiB;
constexpr size_t WS_O = 416 * MiB;
constexpr size_t WS_KV = 480 * MiB;
constexpr size_t WS_END = 488 * MiB;
constexpr int HID_ROWS = 2 * T + NE * 256;

constexpr int CW_CNT = 64;
constexpr int CW_BAR = 4096;

constexpr int RING_BYTES = 131072;
constexpr int LDS_TOK = RING_BYTES;
constexpr int LDS_MISC = RING_BYTES + 8192;
constexpr int LDS_BYTES = 147456;

#define RLX_AGENT __ATOMIC_RELAXED, __HIP_MEMORY_SCOPE_AGENT
#define LDS_WAIT() asm volatile("s_waitcnt lgkmcnt(0)" ::: "memory")
#define VM_WAIT() asm volatile("s_waitcnt vmcnt(0)" ::: "memory")

__device__ __forceinline__ unsigned f2bf(float f) { unsigned u = __builtin_bit_cast(unsigned, f); return (u + 0x7fffu + ((u >> 16) & 1u)) >> 16; }
__device__ __forceinline__ unsigned pk2(float lo, float hi) { return f2bf(lo) | (f2bf(hi) << 16); }
__device__ __forceinline__ float bf2f(unsigned short b) { return __builtin_bit_cast(float, (unsigned)b << 16); }
__device__ __forceinline__ float bflo(unsigned w) { return __builtin_bit_cast(float, w << 16); }
__device__ __forceinline__ float bfhi(unsigned w) { return __builtin_bit_cast(float, w & 0xffff0000u); }

namespace pg8 {
constexpr int BM = 256, BK = 64, HALF = 128, HTB = HALF * BK * 2, STAGE_BYTES = 8 * HTB, NXCD = 8, WGM = 8;
__host__ __device__ __forceinline__ int lds_byte(int r, int c) { const int st = (r >> 4) * 2 + (c >> 5), rr = r & 15, cc = c & 31, ob = rr * 64 + cc * 2; return st * 1024 + (ob ^ (((ob >> 9) & 1) << 5)); }
__host__ __device__ __forceinline__ void stage_rc(int b, int& R, int& C) { const int st = b / 1024, sb = b % 1024, swz = sb ^ (((sb >> 9) & 1) << 5); R = (st >> 1) * 16 + swz / 64; C = (st & 1) * 32 + (swz % 64) / 2; }
__host__ __device__ __forceinline__ int perm32(int rho) { const int n = rho >> 4, i = rho & 15; return 8 * (i >> 2) + 4 * n + (i & 3); }

struct Unit { int pm, pn, aux, idx; };

struct StaticOrder {
    int nM, nN, nwg, G, c;
    __device__ void init(int M, int N, int G_, int c_) { nM = M / BM; nN = N / BM; nwg = nM * nN; G = G_; c = c_; }
    __device__ bool next(int i, Unit& u) const {
        const long L = (long)i * G + c; if (L >= nwg) return false;
        int wgid = (int)L; { const int q = nwg / NXCD, r = nwg % NXCD, xcd = wgid % NXCD, off = wgid / NXCD; wgid = (xcd < r ? xcd * (q + 1) : r * (q + 1) + (xcd - r) * q) + off; }
        const int nig = WGM * nN, gid = wgid / nig, fm = gid * WGM, gsz = (nM - fm) < WGM ? (nM - fm) : WGM;
        u.pm = fm + ((wgid % nig) % gsz); u.pn = (wgid % nig) / gsz; u.aux = 0; u.idx = i; return true;
    }
};
struct TwoHalfOrder {
    StaticOrder s;
    __device__ bool next(int i, Unit& u) const { if (!s.next(i >> 1, u)) return false; u.aux = i & 1; u.idx = i; return true; }
};

__device__ __forceinline__ unsigned cvt_pk_bf16(float lo, float hi) { unsigned r; asm volatile("v_cvt_pk_bf16_f32 %0, %1, %2" : "=v"(r) : "v"(lo), "v"(hi)); return r; }

struct DenseG {
    const bf16* A; const bf16* Bt; int lda, ldb, nt, kaux;
    static constexpr bool GATHER = false;
    __device__ __forceinline__ const char* a_base(const Unit& u) const { return (const char*)(A + (size_t)u.pm * BM * lda + (size_t)u.aux * kaux); }
    __device__ __forceinline__ const char* b_base(const Unit& u) const { return (const char*)(Bt + (size_t)u.pn * BM * ldb + (size_t)u.aux * kaux); }
    __device__ __forceinline__ void a_voff(const Unit&, const int (&R)[2], const int (&C)[2], unsigned (&v)[2][2], const LAS int*) const {
#pragma unroll
        for (int h = 0; h < 2; ++h)
#pragma unroll
            for (int i = 0; i < 2; ++i) v[h][i] = (unsigned)((h * HALF + R[i]) * lda + C[i]) * 2u;
    }
};

template <class G, class Epi, class Sched, bool ALIGN_EPI>
__device__ __forceinline__ void gemm_phase(LAS unsigned char* lds, const LAS int* ltok, const G& g, const Sched& S, const Epi& E) {
    const int tid = threadIdx.x, wid = __builtin_amdgcn_readfirstlane(tid >> 6), lane = tid & 63, wr = wid >> 2, wc = wid & 3, fr = lane & 15, fq = lane >> 4;
    const int nt = g.nt;
    int Rs[2], Cs[2]; unsigned voffB[2];
#pragma unroll
    for (int i = 0; i < 2; ++i) { stage_rc(tid * 16 + i * 8192, Rs[i], Cs[i]); const int Rb = Epi::PERM ? ((Rs[i] & ~31) + perm32(Rs[i] & 31)) : Rs[i];
        voffB[i] = (unsigned)(Rb * g.ldb + Cs[i]) * 2u; }
    const size_t kstep = (size_t)(BK * 2);
    const size_t hstepB = (size_t)HALF * g.ldb * 2;
    const unsigned ldsw = (unsigned)wid * 1024u;
    const int aoff = lds_byte(wr * 64 + fr, fq * 8), boff = lds_byte(wc * 32 + fr, fq * 8);
#define PG8_SA(b, h) (((b) * 2 + (h)) * HTB)
#define PG8_SB(b, h) ((4 + (b) * 2 + (h)) * HTB)
#define PG8_STAGE_A(bufoff, gbase, VO, h) do { _Pragma("unroll") for (int _i = 0; _i < 2; ++_i) \
        __builtin_amdgcn_global_load_lds((const unsigned*)((const char*)(gbase) + (VO)[h][_i]), (LAS unsigned*)(lds + (bufoff) + ldsw + _i * 8192), 16, 0, 0); } while (0)
#define PG8_STAGE_B(bufoff, gbase) do { _Pragma("unroll") for (int _i = 0; _i < 2; ++_i) \
        __builtin_amdgcn_global_load_lds((const unsigned*)((const char*)(gbase) + voffB[_i]), (LAS unsigned*)(lds + (bufoff) + ldsw + _i * 8192), 16, 0, 0); } while (0)
#define PG8_LDA(dst, b, h) do { _Pragma("unroll") for (int m = 0; m < 4; ++m) _Pragma("unroll") for (int k = 0; k < 2; ++k) dst[m][k] = *(const LAS bf16x8*)(lds + PG8_SA(b, h) + aoff + m * 2048 + k * 1024); } while (0)
#define PG8_LDB(dst, b, h) do { _Pragma("unroll") for (int n = 0; n < 2; ++n) _Pragma("unroll") for (int k = 0; k < 2; ++k) dst[n][k] = *(const LAS bf16x8*)(lds + PG8_SB(b, h) + boff + n * 2048 + k * 1024); } while (0)
#define PG8_MMA(ai, bj, At, Bt) do { __builtin_amdgcn_s_setprio(1); _Pragma("unroll") for (int m = 0; m < 4; ++m) _Pragma("unroll") for (int n = 0; n < 2; ++n) _Pragma("unroll") for (int k = 0; k < 2; ++k) \
        acc[ai][bj][m][n] = __builtin_amdgcn_mfma_f32_16x16x32_bf16(Bt[n][k], At[m][k], acc[ai][bj][m][n], 0, 0, 0); __builtin_amdgcn_s_setprio(0); } while (0)
#define PG8_WAIT_V(n) asm volatile("s_waitcnt vmcnt(" #n ")" ::: "memory")
#define PG8_WAIT_L(n) asm volatile("s_waitcnt lgkmcnt(" #n ")" ::: "memory")
#define PG8_BAR __builtin_amdgcn_s_barrier()
#define PG8_SCHED __builtin_amdgcn_sched_barrier(0)
    Unit cur, nxt; int ui = 0;
    if (!S.next(0, cur)) return;
    f32x4 acc[2][2][4][2];
#pragma unroll
    for (int a = 0; a < 2; ++a)
#pragma unroll
        for (int b = 0; b < 2; ++b)
#pragma unroll
            for (int m = 0; m < 4; ++m)
#pragma unroll
                for (int n = 0; n < 2; ++n) acc[a][b][m][n] = (f32x4){0.f, 0.f, 0.f, 0.f};
    bf16x8 At[4][2], B0[2][2], B1[2][2];
    unsigned voAc[2][2], voAn[2][2];
    g.a_voff(cur, Rs, Cs, voAc, ltok);
    const char* cA = g.a_base(cur); const char* cB = g.b_base(cur);
    PG8_STAGE_B(PG8_SB(0, 0), cB); PG8_STAGE_B(PG8_SB(0, 1), cB + hstepB); PG8_STAGE_A(PG8_SA(0, 0), cA, voAc, 0); PG8_STAGE_A(PG8_SA(0, 1), cA, voAc, 1);
    if (wr == 1) PG8_BAR;
    PG8_WAIT_V(2); PG8_BAR;
    PG8_STAGE_B(PG8_SB(1, 0), cB + kstep); PG8_STAGE_A(PG8_SA(1, 0), cA + kstep, voAc, 0); PG8_STAGE_B(PG8_SB(1, 1), cB + hstepB + kstep);
    PG8_WAIT_V(6); PG8_BAR;
    for (;;) {
        const bool has_next = S.next(ui + 1, nxt);
        const char* nA = cA; const char* nB = cB;
        if (has_next) { nA = g.a_base(nxt); nB = g.b_base(nxt); g.a_voff(nxt, Rs, Cs, voAn, ltok); }
        else {
#pragma unroll
            for (int h = 0; h < 2; ++h)
#pragma unroll
                for (int i = 0; i < 2; ++i) voAn[h][i] = voAc[h][i]; }
        for (int t = 0; t < nt; t += 2) {
            const bool last = (t == nt - 2);
            const char* a1 = cA + (size_t)(t + 1) * kstep;
            const char* a2 = last ? nA : cA + (size_t)(t + 2) * kstep; const char* b2 = last ? nB : cB + (size_t)(t + 2) * kstep;
            const char* a3 = a2 + kstep; const char* b3 = b2 + kstep;
            unsigned vo2[2][2];
#pragma unroll
            for (int h = 0; h < 2; ++h)
#pragma unroll
                for (int i = 0; i < 2; ++i) vo2[h][i] = last ? voAn[h][i] : voAc[h][i];
            PG8_LDB(B0, 0, 0); PG8_LDB(B1, 0, 1); PG8_SCHED; PG8_LDA(At, 0, 0); PG8_STAGE_A(PG8_SA(1, 1), a1, voAc, 1);
            PG8_WAIT_V(8); PG8_WAIT_L(0); PG8_BAR; PG8_MMA(0, 0, At, B0); PG8_MMA(0, 1, At, B1); PG8_BAR; PG8_SCHED;
            PG8_LDA(At, 0, 1); PG8_STAGE_B(PG8_SB(0, 0), b2); PG8_STAGE_B(PG8_SB(0, 1), b2 + hstepB); PG8_STAGE_A(PG8_SA(0, 0), a2, vo2, 0);
            PG8_WAIT_V(8); PG8_WAIT_L(0); PG8_BAR; PG8_MMA(1, 0, At, B0); PG8_MMA(1, 1, At, B1); PG8_BAR; PG8_SCHED;
            PG8_LDB(B0, 1, 0); PG8_LDB(B1, 1, 1); PG8_SCHED; PG8_LDA(At, 1, 0); PG8_STAGE_A(PG8_SA(0, 1), a2, vo2, 1);
            PG8_WAIT_V(8); PG8_WAIT_L(0); PG8_BAR; PG8_MMA(0, 0, At, B0); PG8_MMA(0, 1, At, B1); PG8_BAR; PG8_SCHED;
            PG8_LDA(At, 1, 1); PG8_STAGE_B(PG8_SB(1, 0), b3); PG8_STAGE_B(PG8_SB(1, 1), b3 + hstepB); PG8_STAGE_A(PG8_SA(1, 0), a3, vo2, 0);
            PG8_WAIT_V(8); PG8_WAIT_L(0); PG8_BAR; PG8_MMA(1, 0, At, B0); PG8_MMA(1, 1, At, B1); PG8_BAR; PG8_SCHED;
        }
        if constexpr (ALIGN_EPI) { if (wr == 0) PG8_BAR; }
        const bool keep = E(acc, cur, wr, wc, fr, fq);
        if (!has_next) break;
        if (!keep) {
#pragma unroll
            for (int a = 0; a < 2; ++a)
#pragma unroll
                for (int b = 0; b < 2; ++b)
#pragma unroll
                    for (int m = 0; m < 4; ++m)
#pragma unroll
                        for (int n = 0; n < 2; ++n) acc[a][b][m][n] = (f32x4){0.f, 0.f, 0.f, 0.f};
        }
        cur = nxt; cA = nA; cB = nB; ++ui;
#pragma unroll
        for (int h = 0; h < 2; ++h)
#pragma unroll
            for (int i = 0; i < 2; ++i) voAc[h][i] = voAn[h][i];
        if constexpr (ALIGN_EPI) { if (wr == 1) PG8_BAR; }
    }
    PG8_WAIT_V(0);
    if constexpr (!ALIGN_EPI) { if (wr == 0) PG8_BAR; }
    PG8_BAR;
#undef PG8_SA
#undef PG8_SB
#undef PG8_STAGE_A
#undef PG8_STAGE_B
#undef PG8_LDA
#undef PG8_LDB
#undef PG8_MMA
#undef PG8_WAIT_V
#undef PG8_WAIT_L
#undef PG8_BAR
#undef PG8_SCHED
}
}

#define XB_TMO      128
#define XB_XCNT(j)  (256  + 64 * (j))
#define XB_XSUB(j)  (1280 + 64 * (j))
#define XB_XGEN(j)  (2304 + 64 * (j))
#define XB_TOP      3328
#define XB_TOPGEN   3392
#define XCD_BAR_WORDS 3456
#define XB_SPIN_CAP (1u << 18)
__device__ __forceinline__ unsigned xb_ld(unsigned* p)              { return __hip_atomic_load(p, __ATOMIC_RELAXED, __HIP_MEMORY_SCOPE_AGENT); }
__device__ __forceinline__ unsigned xb_add(unsigned* p, unsigned v) { return __hip_atomic_fetch_add(p, v, __ATOMIC_RELAXED, __HIP_MEMORY_SCOPE_AGENT); }
__device__ __forceinline__ unsigned xb_xcc_id() { return (unsigned)__builtin_amdgcn_s_getreg((3 << 11) | 20) & 0xFu; }
#define XB_SPIN(cond, bar) do { unsigned _sp = 0; while (cond) { __builtin_amdgcn_s_sleep(1); \
    if ((++_sp & 255u) == 0u) { if (xb_ld(&(bar)[XB_TMO])) break; if (_sp > XB_SPIN_CAP) { atomicAdd(&(bar)[XB_TMO], 1u); break; } } } } while (0)
struct XcdBarrier { unsigned* bar; unsigned x; volatile LAS unsigned* st; };
__device__ __forceinline__ XcdBarrier xcd_barrier_post(unsigned* bar, volatile LAS unsigned* st) {
    XcdBarrier b; b.bar = bar; b.x = xb_xcc_id(); b.st = st;
    if (threadIdx.x == 0) (void)xb_add(&bar[XB_XCNT(b.x)], 1u);
    return b;
}
__device__ __forceinline__ void xcd_barrier_complete(unsigned* bar, unsigned x, unsigned& nloc, unsigned& nx) {
    const unsigned G = gridDim.x * gridDim.y * gridDim.z;
    unsigned sum, cnt, mine, sp = 0u;
    for (;;) {
        sum = 0u; cnt = 0u; mine = 0u;
#pragma unroll
        for (unsigned j = 0; j < 16; ++j) { const unsigned c = xb_ld(&bar[XB_XCNT(j)]); sum += c; cnt += (c > 0u) ? 1u : 0u; mine = (j == x) ? c : mine; }
        if (sum == G) break;
        __builtin_amdgcn_s_sleep(1);
        if ((++sp & 255u) == 0u) { if (xb_ld(&bar[XB_TMO])) break; if (sp > XB_SPIN_CAP) { atomicAdd(&bar[XB_TMO], 1u); break; } }
    }
    nloc = mine > 0u ? mine : 1u; nx = cnt > 0u ? cnt : 1u;
}
__device__ __forceinline__ void xcd_barrier(const XcdBarrier& b) {
    asm volatile("s_waitcnt vmcnt(0)" ::: "memory");
    __syncthreads();
    if (threadIdx.x == 0) {
        unsigned* bar = b.bar;
        __builtin_amdgcn_s_waitcnt(0);
        unsigned nloc = b.st[0], nx = b.st[1];
        if (nloc == 0u) { xcd_barrier_complete(bar, b.x, nloc, nx); b.st[0] = nloc; b.st[1] = nx; }
        const unsigned old = xb_add(&bar[XB_XSUB(b.x)], 1u);
        const unsigned gen = old / nloc;
        if (old + 1u == (gen + 1u) * nloc) {
            __builtin_amdgcn_fence(__ATOMIC_RELEASE, "agent");
            asm volatile("s_waitcnt vmcnt(0)" ::: "memory");
            const unsigned og = xb_add(&bar[XB_TOP], 1u);
            const unsigned tg = og / nx;
            if (og + 1u == (tg + 1u) * nx) xb_add(&bar[XB_TOPGEN], 1u);
            else XB_SPIN(xb_ld(&bar[XB_TOPGEN]) == tg, bar);
            __builtin_amdgcn_fence(__ATOMIC_ACQUIRE, "agent");
            xb_add(&bar[XB_XGEN(b.x)], 1u);
            asm volatile("s_waitcnt vmcnt(0)" ::: "memory");
        } else {
            XB_SPIN(xb_ld(&bar[XB_XGEN(b.x)]) == gen, bar);
            __builtin_amdgcn_fence(__ATOMIC_ACQUIRE, "agent");
            asm volatile("s_waitcnt vmcnt(0)" ::: "memory");
        }
    }
    __syncthreads();
}

struct Args { const float* in[30]; float* out; unsigned char* ws; int ph_lo, ph_hi; };
struct Frame {
    LAS unsigned char* lds;
    int tid, lane, wave, vcu, G;
    const float* const* in;
    unsigned char* ws; float* out;
};
__device__ __forceinline__ float wave_sum(float v) {
#pragma unroll
    for (int o = 1; o < 64; o <<= 1) v += __shfl_xor(v, o);
    return v;
}

__device__ __forceinline__ void p0_tr_item(const float* W, int N, int k0, int n0, const float* sk, float cs, bf16* WT, int ldt, int drow0, LAS float* scr, int lane) {
#pragma unroll 8
    for (int i = 0; i < 32; ++i) { const int kk = 2 * i + (lane >> 5); const float s = (sk ? sk[k0 + kk] : 1.0f) * cs;
        scr[kk * 33 + (lane & 31)] = W[(size_t)(k0 + kk) * N + n0 + (lane & 31)] * s; }
    LDS_WAIT(); asm volatile("" ::: "memory");
    const int c = lane & 7;
#pragma unroll
    for (int j = 0; j < 4; ++j) { const int n = (lane >> 3) + 8 * j; const LAS float* s = scr + (8 * c) * 33 + n;
        u32x4 o; o.x = pk2(s[0 * 33], s[1 * 33]); o.y = pk2(s[2 * 33], s[3 * 33]); o.z = pk2(s[4 * 33], s[5 * 33]); o.w = pk2(s[6 * 33], s[7 * 33]);
        *(u32x4*)(WT + (size_t)(drow0 + n) * ldt + k0 + 8 * c) = o; }
    LDS_WAIT(); asm volatile("" ::: "memory");
}
__device__ __forceinline__ void p0_prologue(Frame& F) {
    LAS float* scr = (LAS float*)(F.lds + F.wave * 16384);
    const int gw = F.vcu * NWAVES + F.wave, NGW = F.G * NWAVES, lane = F.lane;
    unsigned char* ws = F.ws;
    bf16* WinT = (bf16*)(ws + WS_WIN); bf16* WkvT = (bf16*)(ws + WS_WKV); bf16* WoutT = (bf16*)(ws + WS_WOUT); bf16* WqT = (bf16*)(ws + WS_WQ);
    bf16* WoT = (bf16*)(ws + WS_WO); bf16* WguT = (bf16*)(ws + WS_WGU); bf16* WdT = (bf16*)(ws + WS_WD);
    constexpr int I_IN = 16 * 80, I_SQ = 16 * 32, I_GU = NE * 16 * 16, I_D = NE * 8 * 32;
    constexpr int NITEMS = I_IN + 5 * I_SQ + 2 * I_GU + I_D;
    for (int it = gw; it < NITEMS; it += NGW) {
        int r = it;
        if (r < I_IN) { const int kb = r / 80, nb = r % 80, n0 = nb * 32; const float cs = (n0 >= 1024 && n0 < 1536) ? 0.125f : 1.0f;
            p0_tr_item(F.in[3], DIN, kb * 64, n0, F.in[2], cs, WinT, DM, n0, scr, lane); continue; } r -= I_IN;
        if (r < I_SQ) { const int kb = r / 32, nb = r % 32; const float* sk = (kb < 8) ? F.in[12] : (F.in[13] - 512);
            p0_tr_item(F.in[14], DM, kb * 64, nb * 32, sk, 1.0f, WoutT, DM, nb * 32, scr, lane); continue; } r -= I_SQ;
        if (r < I_SQ) { const int kb = r / 32, nb = r % 32; p0_tr_item(F.in[17], DM, kb * 64, nb * 32, F.in[15], 0.0625f, WqT, DM, nb * 32, scr, lane); continue; } r -= I_SQ;
        if (r < I_SQ) { const int kb = r / 32, nb = r % 32; p0_tr_item(F.in[18], DM, kb * 64, nb * 32, nullptr, 1.0f, WkvT, DM, nb * 32, scr, lane); continue; } r -= I_SQ;
        if (r < I_SQ) { const int kb = r / 32, nb = r % 32; p0_tr_item(F.in[19], DM, kb * 64, nb * 32, nullptr, 1.0f, WkvT, DM, 1024 + nb * 32, scr, lane); continue; } r -= I_SQ;
        if (r < I_SQ) { const int kb = r / 32, nb = r % 32; p0_tr_item(F.in[20], DM, kb * 64, nb * 32, nullptr, 1.0f, WoT, DM, nb * 32, scr, lane); continue; } r -= I_SQ;
        if (r < 2 * I_GU) { const int up = r / I_GU; r -= up * I_GU; const int e = r / 256, q = r % 256, kb = q / 16, nb = q % 16, n0 = nb * 32;
            const int drow = (n0 >> 7) * 256 + up * 128 + (n0 & 127);
            p0_tr_item(F.in[26 + up] + (size_t)e * DM * DE, DE, kb * 64, n0, F.in[21], 1.0f, WguT + (size_t)e * 1024 * 1024, DM, drow, scr, lane); continue; } r -= 2 * I_GU;
        { const int e = r / 256, q = r % 256, kb = q / 32, nb = q % 32;
            p0_tr_item(F.in[28] + (size_t)e * DE * DM, DM, kb * 64, nb * 32, nullptr, 1.0f, WdT + (size_t)e * 1024 * 512, DE, nb * 32, scr, lane); }
    }
    bf16* XB = (bf16*)(ws + WS_XB); float* rstd1 = (float*)(ws + WS_RSTD1); bf16* MEMN = (bf16*)(ws + WS_MEMN);
    for (int m = gw; m < T + MT; m += NGW) {
        const bool isx = m < T; const int row = isx ? m : m - T;
        const f32x4* xr = (const f32x4*)((isx ? F.in[0] : F.in[1]) + (size_t)row * DM) + lane;
        f32x4 v[4]; float s = 0.f;
#pragma unroll
        for (int j = 0; j < 4; ++j) { v[j] = xr[64 * j]; s += (v[j].x * v[j].x + v[j].y * v[j].y) + (v[j].z * v[j].z + v[j].w * v[j].w); }
        const float rstd = 1.0f / sqrtf(wave_sum(s) * (1.0f / DM) + EPS);
        unsigned long long* o8 = (unsigned long long*)((isx ? XB : MEMN) + (size_t)row * DM) + lane;
        if (isx) { if (lane == 0) rstd1[row] = rstd;
#pragma unroll
            for (int j = 0; j < 4; ++j) o8[64 * j] = (unsigned long long)pk2(v[j].x, v[j].y) | ((unsigned long long)pk2(v[j].z, v[j].w) << 32);
        } else { const f32x4* wv = (const f32x4*)F.in[16] + lane;
#pragma unroll
            for (int j = 0; j < 4; ++j) { const f32x4 w = wv[64 * j]; o8[64 * j] = (unsigned long long)pk2(v[j].x * rstd * w.x, v[j].y * rstd * w.y) | ((unsigned long long)pk2(v[j].z * rstd * w.z, v[j].w * rstd * w.w) << 32); }
        }
    }
    bf16* WrT = (bf16*)(ws + WS_WR);
    for (int i = (F.vcu * NTHR + F.tid); i < 64 * DM; i += F.G * NTHR) {
        const int n = i / DM, k = i % DM; float v = 0.f;
        if (n < 4) v = F.in[22][k * 4 + n]; else if (n < 36) { const int gg = (n - 4) >> 3, e = (n - 4) & 7; v = F.in[24][((size_t)gg * DM + k) * 8 + e]; }
        WrT[i] = (bf16)f2bf(v * F.in[21][k]);
    }
}

struct RsNone { __device__ __forceinline__ float operator()(int) const { return 1.0f; } };
struct RsArr { const float* p; __device__ __forceinline__ float operator()(int r) const { return p[r]; } };
struct RsPart16 { const float* p; __device__ __forceinline__ float operator()(int r) const { const f32x4* q = (const f32x4*)(p + (size_t)r * 16); const f32x4 a = q[0], b = q[1], c = q[2], d = q[3];
    const float s = ((a.x + a.y) + (a.z + a.w)) + ((b.x + b.y) + (b.z + b.w)) + ((c.x + c.y) + (c.z + c.w)) + ((d.x + d.y) + (d.z + d.w)); return 1.0f / sqrtf(s * (1.0f / DM) + EPS); } };

template <class RS> struct EpiBf16 {
    static constexpr bool PERM = true;
    bf16* O; int ldc; RS rs;
    __device__ __forceinline__ bool operator()(f32x4 (&acc)[2][2][4][2], const pg8::Unit& u, int wr, int wc, int fr, int fq) const {
        const int row0 = u.pm * 256 + wr * 64 + fr, col0 = u.pn * 256 + wc * 32 + 8 * fq;
#pragma unroll
        for (int ai = 0; ai < 2; ++ai)
#pragma unroll
            for (int m = 0; m < 4; ++m) { const int row = row0 + ai * 128 + m * 16; const float s = rs(row); bf16* rowp = O + (size_t)row * ldc + col0;
#pragma unroll
                for (int bj = 0; bj < 2; ++bj) { const f32x4 v0 = acc[ai][bj][m][0] * s, v1 = acc[ai][bj][m][1] * s; u32x4 w;
                    w.x = pg8::cvt_pk_bf16(v0[0], v0[1]); w.y = pg8::cvt_pk_bf16(v0[2], v0[3]); w.z = pg8::cvt_pk_bf16(v1[0], v1[1]); w.w = pg8::cvt_pk_bf16(v1[2], v1[3]);
                    *(u32x4*)(rowp + bj * 128) = w; } }
        return false;
    }
};

template <bool MIX, bool RESBF> struct EpiRes {
    static constexpr bool PERM = true;
    const float* resf; bf16* xb; float* ssq;
    const LAS float* stab;
    __device__ __forceinline__ bool operator()(f32x4 (&acc)[2][2][4][2], const pg8::Unit& u, int wr, int wc, int fr, int fq) const {
        const int rt0 = wr * 64 + fr, row0 = u.pm * 256 + rt0, col0 = u.pn * 256 + wc * 32 + 8 * fq;
        const LAS float* st = stab + ((u.idx >> 1) & 3) * 512;
        if (MIX && u.aux == 0) {
#pragma unroll
            for (int ai = 0; ai < 2; ++ai)
#pragma unroll
                for (int m = 0; m < 4; ++m) { const float q = st[(rt0 + ai * 128 + m * 16) * 2];
#pragma unroll
                    for (int bj = 0; bj < 2; ++bj)
#pragma unroll
                        for (int n = 0; n < 2; ++n) acc[ai][bj][m][n] = acc[ai][bj][m][n] * q; }
            return true;
        }
#pragma unroll
        for (int ai = 0; ai < 2; ++ai)
#pragma unroll
            for (int m = 0; m < 4; ++m) { const int row = row0 + ai * 128 + m * 16; float s = 1.0f;
                if (MIX) s = st[(rt0 + ai * 128 + m * 16) * 2 + 1];
                const size_t off = (size_t)row * DM + col0; float q = 0.f;
#pragma unroll
                for (int bj = 0; bj < 2; ++bj) { f32x4 r0, r1;
                    if (RESBF) { const u32x4 rw = *(const u32x4*)(xb + off + bj * 128); r0 = (f32x4){bflo(rw.x), bfhi(rw.x), bflo(rw.y), bfhi(rw.y)}; r1 = (f32x4){bflo(rw.z), bfhi(rw.z), bflo(rw.w), bfhi(rw.w)}; }
                    else { r0 = *(const f32x4*)(resf + off + bj * 128); r1 = *(const f32x4*)(resf + off + bj * 128 + 4); }
                    const f32x4 v0 = r0 + acc[ai][bj][m][0] * s, v1 = r1 + acc[ai][bj][m][1] * s; u32x4 w;
                    w.x = pg8::cvt_pk_bf16(v0[0], v0[1]); w.y = pg8::cvt_pk_bf16(v0[2], v0[3]); w.z = pg8::cvt_pk_bf16(v1[0], v1[1]); w.w = pg8::cvt_pk_bf16(v1[2], v1[3]);
                    *(u32x4*)(xb + off + bj * 128) = w;
                    q += ((v0[0] * v0[0] + v0[1] * v0[1]) + (v0[2] * v0[2] + v0[3] * v0[3])) + ((v1[0] * v1[0] + v1[1] * v1[1]) + (v1[2] * v1[2] + v1[3] * v1[3])); }
                q += __shfl_xor(q, 16); q += __shfl_xor(q, 32);
                if (fq == 0) ssq[(size_t)row * 16 + u.pn * 4 + wc] = q; }
        return false;
    }
};
__device__ __forceinline__ void p3_scale_table(Frame& F, const pg8::StaticOrder& S, LAS float* stab) {
    const float* ssqr = (const float*)(F.ws + WS_SSQR); const float* ssqa = (const float*)(F.ws + WS_SSQA);
    pg8::Unit u;
    for (int i = 0; i < 4 && S.next(i, u); ++i) {
        if (F.tid < 256) { const int row = u.pm * 256 + F.tid; float sr = 0.f, sa = 0.f;
#pragma unroll 8
            for (int j = 0; j < 32; ++j) sr += ssqr[(size_t)j * T + row];
#pragma unroll
            for (int j = 0; j < 8; ++j) sa += ssqa[(size_t)j * T + row];
            const float rr = 1.0f / sqrtf(sr * (1.0f / DRNN) + EPS), ra = 1.0f / sqrtf(sa * (1.0f / DATT) + EPS);
            stab[(i * 256 + F.tid) * 2] = rr / ra; stab[(i * 256 + F.tid) * 2 + 1] = ra; }
    }
    __syncthreads();
}

struct MoeTab { int mt_pref[NE + 1]; };
struct MoeOrder {
    const LAS int* pref;
    int G, c, ntile;
    __device__ __forceinline__ bool next(int i, pg8::Unit& u) const {
        const int L = i * G + c; if (L >= ntile * 4) return false;
        const int tl = L >> 2; u.pn = L & 3;
        int e = 0;
#pragma unroll
        for (int j = 1; j < NE; ++j) e += (pref[j] <= tl) ? 1 : 0;
        u.aux = e; u.pm = tl; u.idx = i; return true;
    }
};
struct GatherG {
    const bf16* A; const bf16* Bt; int lda, ldb, nt;
    static constexpr bool GATHER = true;
    __device__ __forceinline__ const char* a_base(const pg8::Unit&) const { return (const char*)A; }
    __device__ __forceinline__ const char* b_base(const pg8::Unit& u) const { return (const char*)(Bt + ((size_t)u.aux * 1024 + (size_t)u.pn * 256) * ldb); }
    __device__ __forceinline__ void a_voff(const pg8::Unit& u, const int (&R)[2], const int (&C)[2], unsigned (&v)[2][2], const LAS int* ltok) const {
#pragma unroll
        for (int h = 0; h < 2; ++h)
#pragma unroll
            for (int i = 0; i < 2; ++i) { const int tok = ltok[(u.idx & 7) * 256 + h * 128 + R[i]] >> 1; v[h][i] = (unsigned)(tok * lda + C[i]) * 2u; }
    }
};
struct DownG {
    const bf16* A; const bf16* Bt; int lda, ldb, nt;
    static constexpr bool GATHER = false;
    __device__ __forceinline__ const char* a_base(const pg8::Unit& u) const { return (const char*)(A + (size_t)u.pm * 256 * lda); }
    __device__ __forceinline__ const char* b_base(const pg8::Unit& u) const { return (const char*)(Bt + ((size_t)u.aux * 1024 + (size_t)u.pn * 256) * ldb); }
    __device__ __forceinline__ void a_voff(const pg8::Unit&, const int (&R)[2], const int (&C)[2], unsigned (&v)[2][2], const LAS int*) const {
#pragma unroll
        for (int h = 0; h < 2; ++h)
#pragma unroll
            for (int i = 0; i < 2; ++i) v[h][i] = (unsigned)((h * 128 + R[i]) * lda + C[i]) * 2u;
    }
};
struct EpiGateUp {
    static constexpr bool PERM = true;
    bf16* H; const LAS int* ltok; RsPart16 rs;
    __device__ __forceinline__ bool operator()(f32x4 (&acc)[2][2][4][2], const pg8::Unit& u, int wr, int wc, int fr, int fq) const {
        const int rt0 = wr * 64 + fr, row0 = u.pm * 256 + rt0, col0 = u.pn * 128 + wc * 32 + 8 * fq;
#pragma unroll
        for (int ai = 0; ai < 2; ++ai)
#pragma unroll
            for (int m = 0; m < 4; ++m) { bf16* rowp = H + (size_t)(row0 + ai * 128 + m * 16) * DE + col0; float h[8];
                int sl = ltok[(u.idx & 7) * 256 + rt0 + ai * 128 + m * 16]; sl = sl < 0 ? 0 : sl; const float rstd = rs(sl >> 1);
#pragma unroll
                for (int n = 0; n < 2; ++n)
#pragma unroll
                    for (int j = 0; j < 4; ++j) { const float gv = acc[ai][0][m][n][j] * rstd, uv = acc[ai][1][m][n][j] * rstd; h[n * 4 + j] = gv / (1.0f + __expf(-gv)) * uv; }
                u32x4 w; w.x = pg8::cvt_pk_bf16(h[0], h[1]); w.y = pg8::cvt_pk_bf16(h[2], h[3]); w.z = pg8::cvt_pk_bf16(h[4], h[5]); w.w = pg8::cvt_pk_bf16(h[6], h[7]);
                *(u32x4*)rowp = w; }
        return false;
    }
};
struct EpiDown {
    static constexpr bool PERM = true;
    bf16* Y; const float* slotw; const LAS int* ltok;
    __device__ __forceinline__ bool operator()(f32x4 (&acc)[2][2][4][2], const pg8::Unit& u, int wr, int wc, int fr, int fq) const {
        const int col0 = u.pn * 256 + wc * 32 + 8 * fq;
#pragma unroll
        for (int ai = 0; ai < 2; ++ai)
#pragma unroll
            for (int m = 0; m < 4; ++m) { const int slot = ltok[(u.idx & 7) * 256 + ai * 128 + wr * 64 + m * 16 + fr];
                if (slot >= 0) { const float s = slotw[slot]; bf16* rowp = Y + (size_t)slot * DM + col0;
#pragma unroll
                    for (int bj = 0; bj < 2; ++bj) { const f32x4 v0 = acc[ai][bj][m][0] * s, v1 = acc[ai][bj][m][1] * s; u32x4 w;
                        w.x = pg8::cvt_pk_bf16(v0[0], v0[1]); w.y = pg8::cvt_pk_bf16(v0[2], v0[3]); w.z = pg8::cvt_pk_bf16(v1[0], v1[1]); w.w = pg8::cvt_pk_bf16(v1[2], v1[3]);
                        *(u32x4*)(rowp + bj * 128) = w; } } }
        return false;
    }
};

__device__ __forceinline__ float sigmoidf_(float x) { return 1.0f / (1.0f + __expf(-x)); }
__device__ __forceinline__ float gelu_tanh(float x) { const float u = 0.7978845608028654f * (x + 0.044715f * x * x * x); return 0.5f * x * (1.0f + tanhf(u)); }

constexpr int RT = 256;
constexpr int RB_XR = 0;
constexpr int RB_XG = 37376;
constexpr int RB_SIZE = 45568;
constexpr int R_AGG = 2 * RB_SIZE;
constexpr int R_BW = R_AGG + 2048;
__device__ __forceinline__ float fast_sigmoid(float x) { return __builtin_amdgcn_rcpf(1.0f + __expf(-x)); }
__device__ __forceinline__ void rnn_item(Frame& F, int item) {
    const int b = item >> 5, cb = (item >> 2) & 7, sl = item & 3;
    const int tid = F.tid, lane = F.lane, wave = F.wave;
    LAS unsigned char* lds = F.lds;
    const bf16* proj = (const bf16*)(F.ws + WS_PROJ);
    bf16* ymix = (bf16*)(F.ws + WS_YMIX); float* ssqr = (float*)(F.ws + WS_SSQR);
    const int d = lane & 15, q4 = lane >> 4;
    const int chd = cb * 64 + sl * 16 + d;
    float cbr = F.in[7][chd], cbi = F.in[9][chd];
    __syncthreads();
    {
        const float* wa = F.in[6] + (size_t)cb * 64 * 64 + sl * 16 + d; const float* wx = F.in[8] + (size_t)cb * 64 * 64 + sl * 16 + d;
        const int gsel = wave >> 2, jj = wave & 3; const float* wsel = gsel ? wx : wa;
#pragma unroll
        for (int ks = 0; ks < 2; ++ks) { bf16x8 fr;
#pragma unroll
            for (int j = 0; j < 8; ++j) { const int c = 32 * ks + 8 * q4 + j; fr[j] = (short)f2bf(F.in[4][jj * DRNN + cb * 64 + c] * wsel[c * 64]); }
            *(LAS bf16x8*)(lds + R_BW + (((gsel * 4 + jj) * 2 + ks) * 64 + lane) * 16) = fr; }
        for (int c = 0; c < 64; ++c) { const float cbv = F.in[5][cb * 64 + c]; cbr += cbv * wa[c * 64]; cbi += cbv * wx[c * 64]; }
    }
    float cwd[4]; const float cbd = F.in[5][chd];
#pragma unroll
    for (int jj = 0; jj < 4; ++jj) cwd[jj] = F.in[4][jj * DRNN + chd];
    const float spc = -8.0f * log1pf(__expf(-F.in[10][chd]));
    float tcarry = 0.f;
    const bf16* xrbase = proj + (size_t)b * SEQ * DIN + cb * 64;
    const bf16* xgbase = proj + (size_t)b * SEQ * DIN + DRNN + cb * 64 + sl * 16;
    u32x4 pf[5], pg;
    auto issue = [&](int t0) {
#pragma unroll
        for (int k = 0; k < 5; ++k) { const int p = tid + 512 * k; const int row = p >> 3, c8 = p & 7; const int tk = t0 - 3 + row;
            pf[k] = (u32x4){0u, 0u, 0u, 0u};
            if ((k < 4 || tid < 24) && tk >= 0) pf[k] = *(const u32x4*)(xrbase + (size_t)tk * DIN + c8 * 8); }
        pg = *(const u32x4*)(xgbase + (size_t)(t0 + (tid >> 1)) * DIN + (tid & 1) * 8);
    };
    auto commit = [&](LAS unsigned char* buf) {
#pragma unroll
        for (int k = 0; k < 5; ++k) { const int p = tid + 512 * k; const int row = p >> 3, c8 = p & 7;
            if (k < 4 || tid < 24) *(LAS u32x4*)(buf + RB_XR + row * 144 + c8 * 16) = pf[k]; }
        *(LAS u32x4*)(buf + RB_XG + (tid >> 1) * 32 + (tid & 1) * 16) = pg;
    };
    issue(0); commit(lds);
    __syncthreads();
    for (int tile = 0; tile < SEQ / RT; ++tile) {
        const int t0 = tile * RT, cur = tile & 1;
        LAS unsigned char* buf = lds + cur * RB_SIZE;
        if (tile + 1 < SEQ / RT) issue(t0 + RT);
        float Pt[2][4], hl[2][4], gx[2][4];
        float Ac = 1.f, Hc = 0.f;
#pragma unroll
        for (int rt = 0; rt < 2; ++rt) {
            const int tb = 32 * wave + 16 * rt;
            f32x4 cr = {0.f, 0.f, 0.f, 0.f}, ci = {0.f, 0.f, 0.f, 0.f};
#pragma unroll
            for (int jj = 0; jj < 4; ++jj)
#pragma unroll
                for (int ks = 0; ks < 2; ++ks) { const bf16x8 a = *(const LAS bf16x8*)(buf + RB_XR + (tb + d + jj) * 144 + (32 * ks + 8 * q4) * 2);
                    const bf16x8 fa = *(const LAS bf16x8*)(lds + R_BW + ((jj * 2 + ks) * 64 + lane) * 16), fx = *(const LAS bf16x8*)(lds + R_BW + (((4 + jj) * 2 + ks) * 64 + lane) * 16);
                    cr = __builtin_amdgcn_mfma_f32_16x16x32_bf16(a, fa, cr, 0, 0, 0); ci = __builtin_amdgcn_mfma_f32_16x16x32_bf16(a, fx, ci, 0, 0, 0); }
            float xr7[7];
#pragma unroll
            for (int r = 0; r < 7; ++r) xr7[r] = bf2f(*(const LAS unsigned short*)(buf + RB_XR + (tb + 4 * q4 + r) * 144 + (sl * 16 + d) * 2));
            float av[4], uv[4];
#pragma unroll
            for (int j = 0; j < 4; ++j) { const float xc = cbd + cwd[0] * xr7[j] + cwd[1] * xr7[j + 1] + cwd[2] * xr7[j + 2] + cwd[3] * xr7[j + 3];
                const float r = fast_sigmoid(cr[j] + cbr), ig = fast_sigmoid(ci[j] + cbi); const float a = __expf(spc * r);
                av[j] = a; uv[j] = __builtin_amdgcn_sqrtf(fmaxf(1.0f - a * a, 0.f)) * (ig * xc);
                const float xg = bf2f(*(const LAS unsigned short*)(buf + RB_XG + (tb + 4 * q4 + j) * 32 + d * 2));
                const float uu = 0.7978845608028654f * (xg + 0.044715f * xg * xg * xg); gx[rt][j] = xg * __builtin_amdgcn_rcpf(1.0f + __expf(-2.0f * uu)); }
            float p[4], h[4];
            p[0] = av[0]; h[0] = uv[0];
#pragma unroll
            for (int j = 1; j < 4; ++j) { p[j] = av[j] * p[j - 1]; h[j] = av[j] * h[j - 1] + uv[j]; }
            float A = p[3], H = h[3];
            { const float A1 = __shfl_up(A, 16), H1 = __shfl_up(H, 16); if (q4 >= 1) { H = A * H1 + H; A = A * A1; } }
            { const float A2 = __shfl_up(A, 32), H2 = __shfl_up(H, 32); if (q4 >= 2) { H = A * H2 + H; A = A * A2; } }
            float Ae = __shfl_up(A, 16), He = __shfl_up(H, 16); if (q4 == 0) { Ae = 1.f; He = 0.f; }
            const float Art = __shfl(A, 48 + d), Hrt = __shfl(H, 48 + d);
            const float hin = Ae * Hc + He, Pin = Ac * Ae;
#pragma unroll
            for (int j = 0; j < 4; ++j) { hl[rt][j] = p[j] * hin + h[j]; Pt[rt][j] = Pin * p[j]; }
            Hc = Art * Hc + Hrt; Ac = Ac * Art;
        }
        LAS float* agg = (LAS float*)(lds + R_AGG) + cur * 256;
        if (q4 == 0) { agg[wave * 32 + d] = Ac; agg[wave * 32 + 16 + d] = Hc; }
        if (tile + 1 < SEQ / RT) commit(lds + (cur ^ 1) * RB_SIZE);
        __syncthreads();
        float hin = tcarry, myh = 0.f;
#pragma unroll
        for (int w = 0; w < 8; ++w) { if (w == wave) myh = hin; hin = agg[w * 32 + d] * hin + agg[w * 32 + 16 + d]; }
        tcarry = hin;
#pragma unroll
        for (int rt = 0; rt < 2; ++rt) {
            const int tb = 32 * wave + 16 * rt; const size_t row0 = (size_t)b * SEQ + t0 + tb + 4 * q4;
            float s2[4];
#pragma unroll
            for (int j = 0; j < 4; ++j) { const float hv = hl[rt][j] + Pt[rt][j] * myh; const float y = gx[rt][j] * hv;
                ymix[(row0 + j) * DM + chd] = (bf16)f2bf(y); s2[j] = y * y; }
#pragma unroll
            for (int j = 0; j < 4; ++j) { s2[j] += __shfl_xor(s2[j], 1); s2[j] += __shfl_xor(s2[j], 2); s2[j] += __shfl_xor(s2[j], 4); s2[j] += __shfl_xor(s2[j], 8); }
            if (d == 0) *(f32x4*)(ssqr + (size_t)(cb * 4 + sl) * T + row0) = (f32x4){s2[0], s2[1], s2[2], s2[3]};
        }
    }
    __syncthreads();
}

constexpr int A_VT = 0;
constexpr int A_BIAS = 8 * 9216;
__device__ __forceinline__ void attn_item(Frame& F, int item) {
    const int b = item & 7, c = item >> 3;
    const int lane = F.lane, h = F.wave, r32 = lane & 31, hi = lane >> 5;
    const bf16* proj = (const bf16*)(F.ws + WS_PROJ);
    bf16* ymix = (bf16*)(F.ws + WS_YMIX); float* ssqa = (float*)(F.ws + WS_SSQA);
    LAS unsigned char* vt = F.lds + A_VT + h * 9216;
    LAS float* bl = (LAS float*)(F.lds + A_BIAS + h * 1040);
    for (int i = lane; i < 257; i += 64) bl[i] = F.in[11][h * 257 + i];
    const size_t qrow0 = (size_t)b * SEQ + c * CHUNK;
    const bf16* qptr = proj + (qrow0 + r32) * DIN + 1024 + h * HD + hi * 8;
    f32x16 o[2][2];
#pragma unroll
    for (int i = 0; i < 2; ++i)
#pragma unroll
        for (int j = 0; j < 2; ++j)
#pragma unroll
            for (int r = 0; r < 16; ++r) o[i][j][r] = 0.f;
    float mrun[2] = {-1e30f, -1e30f}, lrun[2] = {0.f, 0.f};
    const float bfar = F.in[11][h * 257 + 256];
    LDS_WAIT();
    const int jc0 = c - LEFT > 0 ? c - LEFT : 0;
    for (int jc = jc0; jc <= c; ++jc) {
        const size_t krow0 = (size_t)b * SEQ + jc * CHUNK;
#pragma unroll
        for (int p = 0; p < 8; ++p) { const int key = p * 8 + (lane >> 3), ch = lane & 7;
            const u32x4 v = *(const u32x4*)(proj + (krow0 + key) * DIN + 2048 + h * HD + ch * 8);
            *(LAS u32x4*)(vt + key * 144 + ch * 16) = v; if (p == 3) asm volatile("" ::: "memory"); }
        asm volatile("" ::: "memory");
        const int dc = c - jc;
        LDS_WAIT();
#pragma unroll
        for (int kb = 0; kb < 2; ++kb) {
            f32x16 s[2];
            {
                bf16x8 kf[4];
#pragma unroll
                for (int ks = 0; ks < 4; ++ks) kf[ks] = *(const bf16x8*)(proj + (krow0 + kb * 32 + r32) * DIN + 1536 + h * HD + ks * 16 + hi * 8);
#pragma unroll
                for (int qb = 0; qb < 2; ++qb) { f32x16 z;
#pragma unroll
                    for (int r = 0; r < 16; ++r) z[r] = 0.f;
#pragma unroll
                    for (int ks = 0; ks < 4; ++ks) { const bf16x8 qf = *(const bf16x8*)(qptr + (size_t)qb * 32 * DIN + ks * 16); z = __builtin_amdgcn_mfma_f32_32x32x16_bf16(kf[ks], qf, z, 0, 0, 0); }
                    s[qb] = z; }
            }
            if (dc >= 3) {
#pragma unroll
                for (int qb = 0; qb < 2; ++qb)
#pragma unroll
                    for (int r = 0; r < 16; ++r) s[qb][r] += bfar;
            } else {
#pragma unroll
                for (int qb = 0; qb < 2; ++qb)
#pragma unroll
                    for (int r = 0; r < 16; ++r) { const int kk = kb * 32 + (r & 3) + 8 * (r >> 2) + 4 * hi; int dist = dc * 64 + qb * 32 + r32 - kk; dist = dist > 128 ? 128 : dist;
                        s[qb][r] += bl[dist + 128]; }
            }
            bf16x8 pf[2][2];
#pragma unroll
            for (int qb = 0; qb < 2; ++qb) {
                float mx = s[qb][0];
#pragma unroll
                for (int r = 1; r < 16; ++r) mx = fmaxf(mx, s[qb][r]);
                mx = fmaxf(mx, __shfl_xor(mx, 32));
                const float mn = fmaxf(mrun[qb], mx); const float alpha = __expf(mrun[qb] - mn); mrun[qb] = mn;
                float sum = 0.f;
#pragma unroll
                for (int r = 0; r < 16; ++r) { const float p = __expf(s[qb][r] - mn); s[qb][r] = p; sum += p; }
                lrun[qb] = lrun[qb] * alpha + sum;
#pragma unroll
                for (int db = 0; db < 2; ++db)
#pragma unroll
                    for (int r = 0; r < 16; ++r) o[db][qb][r] *= alpha;
#pragma unroll
                for (int s2 = 0; s2 < 2; ++s2) { u32x4 w;
                    w.x = pg8::cvt_pk_bf16(s[qb][8 * s2 + 0], s[qb][8 * s2 + 1]); w.y = pg8::cvt_pk_bf16(s[qb][8 * s2 + 2], s[qb][8 * s2 + 3]);
                    w.z = pg8::cvt_pk_bf16(s[qb][8 * s2 + 4], s[qb][8 * s2 + 5]); w.w = pg8::cvt_pk_bf16(s[qb][8 * s2 + 6], s[qb][8 * s2 + 7]);
                    pf[qb][s2] = __builtin_bit_cast(bf16x8, w); }
            }
#pragma unroll
            for (int s2 = 0; s2 < 2; ++s2)
#pragma unroll
                for (int db = 0; db < 2; ++db) {
                    const int key0 = 32 * kb + 16 * s2 + 4 * hi, li = lane & 15, dg = (lane >> 4) & 1;
                    const LAS unsigned char* p0 = vt + (key0 + (li >> 2)) * 144 + (32 * db + 16 * dg + 4 * (li & 3)) * 2;
                    const s16x4 v0 = __builtin_bit_cast(s16x4, __builtin_amdgcn_ds_read_tr16_b64_v4i16((LAS s16x4*)p0));
                    const s16x4 v1 = __builtin_bit_cast(s16x4, __builtin_amdgcn_ds_read_tr16_b64_v4i16((LAS s16x4*)(p0 + 8 * 144)));
                    const bf16x8 vf = (bf16x8){v0[0], v0[1], v0[2], v0[3], v1[0], v1[1], v1[2], v1[3]};
#pragma unroll
                    for (int qb = 0; qb < 2; ++qb) o[db][qb] = __builtin_amdgcn_mfma_f32_32x32x16_bf16(vf, pf[qb][s2], o[db][qb], 0, 0, 0);
                }
        }
        LDS_WAIT();
    }
#pragma unroll
    for (int qb = 0; qb < 2; ++qb) {
        const float l = lrun[qb] + __shfl_xor(lrun[qb], 32); const float il = 1.0f / l;
        const size_t row = qrow0 + qb * 32 + r32; float s2 = 0.f;
#pragma unroll
        for (int db = 0; db < 2; ++db)
#pragma unroll
            for (int g4 = 0; g4 < 4; ++g4) { const float v0 = o[db][qb][4 * g4 + 0] * il, v1 = o[db][qb][4 * g4 + 1] * il, v2 = o[db][qb][4 * g4 + 2] * il, v3 = o[db][qb][4 * g4 + 3] * il;
                s2 += (v0 * v0 + v1 * v1) + (v2 * v2 + v3 * v3);
                u32x2 w; w.x = pg8::cvt_pk_bf16(v0, v1); w.y = pg8::cvt_pk_bf16(v2, v3);
                *(u32x2*)(ymix + row * DM + DRNN + h * HD + db * 32 + 8 * g4 + 4 * hi) = w; }
        s2 += __shfl_xor(s2, 32);
        if (hi == 0) ssqa[(size_t)h * T + row] = s2;
    }
}
__device__ __forceinline__ void p2_mixers(Frame& F) {
    for (int it = blockIdx.x; it < 256; it += F.G) rnn_item(F, it);
    for (int it = blockIdx.x; it < BATCH * NCHUNK; it += F.G) { attn_item(F, it); __syncthreads(); }
}

constexpr int X_VT = 0;
__device__ __forceinline__ void xattn_item(Frame& F, int item) {
    const int b = item & 7, hd = (item >> 3) & 3, qt = item >> 5;
    const int lane = F.lane, wave = F.wave, tid = F.tid, r32 = lane & 31, hi = lane >> 5;
    const bf16* qx = (const bf16*)(F.ws + WS_QX); const bf16* kv = (const bf16*)(F.ws + WS_KV); bf16* O = (bf16*)(F.ws + WS_O);
    LAS unsigned char* vt = F.lds + X_VT;
    const size_t qrow = (size_t)b * SEQ + qt * 256 + wave * 32 + r32;
    const bf16* qp = qx + qrow * DM + hd * XD + hi * 8;
    const bf16* kp = kv + ((size_t)b * NMEM + r32) * 2048 + hd * XD + hi * 8;
    f32x16 s[8];
#pragma unroll
    for (int kb = 0; kb < 8; ++kb)
#pragma unroll
        for (int r = 0; r < 16; ++r) s[kb][r] = 0.f;
#pragma unroll 2
    for (int ks = 0; ks < 16; ++ks) {
        const bf16x8 qf = *(const bf16x8*)(qp + ks * 16);
#pragma unroll
        for (int kb = 0; kb < 8; ++kb) { const bf16x8 kf = *(const bf16x8*)(kp + (size_t)kb * 32 * 2048 + ks * 16);
            s[kb] = __builtin_amdgcn_mfma_f32_32x32x16_bf16(kf, qf, s[kb], 0, 0, 0); }
    }
    float mx = s[0][0];
#pragma unroll
    for (int kb = 0; kb < 8; ++kb)
#pragma unroll
        for (int r = 0; r < 16; ++r) mx = fmaxf(mx, s[kb][r]);
    mx = fmaxf(mx, __shfl_xor(mx, 32));
    float sum = 0.f;
    bf16x8 pf[8][2];
#pragma unroll
    for (int kb = 0; kb < 8; ++kb) {
#pragma unroll
        for (int r = 0; r < 16; ++r) { const float p = __expf(s[kb][r] - mx); s[kb][r] = p; sum += p; }
#pragma unroll
        for (int s2 = 0; s2 < 2; ++s2) { u32x4 w;
            w.x = pg8::cvt_pk_bf16(s[kb][8 * s2 + 0], s[kb][8 * s2 + 1]); w.y = pg8::cvt_pk_bf16(s[kb][8 * s2 + 2], s[kb][8 * s2 + 3]);
            w.z = pg8::cvt_pk_bf16(s[kb][8 * s2 + 4], s[kb][8 * s2 + 5]); w.w = pg8::cvt_pk_bf16(s[kb][8 * s2 + 6], s[kb][8 * s2 + 7]);
            pf[kb][s2] = __builtin_bit_cast(bf16x8, w); }
    }
    sum += __shfl_xor(sum, 32);
    const float il = 1.0f / sum;
    f32x16 o[8];
#pragma unroll
    for (int db = 0; db < 8; ++db)
#pragma unroll
        for (int r = 0; r < 16; ++r) o[db][r] = 0.f;
#pragma unroll
    for (int kt = 0; kt < 4; ++kt) {
        __syncthreads();
#pragma unroll
        for (int p = 0; p < 4; ++p) { const int key = p * 16 + (tid >> 5), ch = tid & 31;
            const u32x4 v = *(const u32x4*)(kv + ((size_t)b * NMEM + kt * 64 + key) * 2048 + 1024 + hd * XD + ch * 8);
            *(LAS u32x4*)(vt + key * 528 + ch * 16) = v; }
        __syncthreads();
#pragma unroll
        for (int kb2 = 0; kb2 < 2; ++kb2)
#pragma unroll
            for (int s2 = 0; s2 < 2; ++s2) {
                const int key0 = 32 * kb2 + 16 * s2 + 4 * hi, li = lane & 15, dg = (lane >> 4) & 1;
                const LAS unsigned char* pb = vt + (key0 + (li >> 2)) * 528 + (16 * dg + 4 * (li & 3)) * 2;
#pragma unroll
                for (int db = 0; db < 8; ++db) {
                    const s16x4 v0 = __builtin_bit_cast(s16x4, __builtin_amdgcn_ds_read_tr16_b64_v4i16((LAS s16x4*)(pb + db * 64)));
                    const s16x4 v1 = __builtin_bit_cast(s16x4, __builtin_amdgcn_ds_read_tr16_b64_v4i16((LAS s16x4*)(pb + db * 64 + 8 * 528)));
                    const bf16x8 vf = (bf16x8){v0[0], v0[1], v0[2], v0[3], v1[0], v1[1], v1[2], v1[3]};
                    o[db] = __builtin_amdgcn_mfma_f32_32x32x16_bf16(vf, pf[kt * 2 + kb2][s2], o[db], 0, 0, 0);
                }
            }
    }
    bf16* op = O + qrow * DM + hd * XD + 4 * hi;
#pragma unroll
    for (int db = 0; db < 8; ++db)
#pragma unroll
        for (int g4 = 0; g4 < 4; ++g4) { u32x2 w; w.x = pg8::cvt_pk_bf16(o[db][4 * g4 + 0] * il, o[db][4 * g4 + 1] * il); w.y = pg8::cvt_pk_bf16(o[db][4 * g4 + 2] * il, o[db][4 * g4 + 3] * il);
            *(u32x2*)(op + db * 32 + 8 * g4) = w; }
}

constexpr int RL_W = 0;
constexpr int RL_LOG = 99328;
constexpr int RL_CNT = RL_LOG + 20480;
__device__ __forceinline__ void p7_router(Frame& F) {
    const int lane = F.lane, wave = F.wave, tid = F.tid, fr = lane & 15, fq = lane >> 4;
    const bf16* xb = (const bf16*)(F.ws + WS_XB); const bf16* WrT = (const bf16*)(F.ws + WS_WR);
    const float* ssq2 = (const float*)(F.ws + WS_SSQ2);
    float* slotw = (float*)(F.ws + WS_SLOTW); int* list = (int*)(F.ws + WS_LIST);
    unsigned* gcnt = (unsigned*)(F.ws + WS_CTL) + CW_CNT;
    LAS float* lg = (LAS float*)(F.lds + RL_LOG) + wave * 16 * 40;
    LAS int* lcnt = (LAS int*)(F.lds + RL_CNT); LAS int* lbase = lcnt + 32;
#pragma unroll
    for (int k = 0; k < 12; ++k) { const int p = tid + 512 * k, row = p >> 7, c = p & 127;
        *(LAS u32x4*)(F.lds + RL_W + row * 2064 + c * 16) = *(const u32x4*)(WrT + (size_t)row * DM + c * 8); }
    for (int blk = blockIdx.x; blk < T / 128; blk += F.G) {
        const int tok0 = blk * 128 + wave * 16;
        if (tid < 32) lcnt[tid] = 0;
        __syncthreads();
        f32x4 c0 = {0.f, 0.f, 0.f, 0.f}, c1 = c0, c2 = c0;
        const bf16* ap = xb + (size_t)(tok0 + fr) * DM + fq * 8;
        const LAS unsigned char* bp = F.lds + RL_W + fr * 2064 + fq * 16;
#pragma unroll 8
        for (int ks = 0; ks < 32; ++ks) { const bf16x8 a = *(const bf16x8*)(ap + ks * 32);
            const bf16x8 b0 = *(const LAS bf16x8*)(bp + ks * 64), b1 = *(const LAS bf16x8*)(bp + 16 * 2064 + ks * 64), b2 = *(const LAS bf16x8*)(bp + 32 * 2064 + ks * 64);
            c0 = __builtin_amdgcn_mfma_f32_16x16x32_bf16(a, b0, c0, 0, 0, 0); c1 = __builtin_amdgcn_mfma_f32_16x16x32_bf16(a, b1, c1, 0, 0, 0); c2 = __builtin_amdgcn_mfma_f32_16x16x32_bf16(a, b2, c2, 0, 0, 0); }
#pragma unroll
        for (int j = 0; j < 4; ++j) { lg[(4 * fq + j) * 40 + fr] = c0[j]; lg[(4 * fq + j) * 40 + 16 + fr] = c1[j]; if (fr < 8) lg[(4 * fq + j) * 40 + 32 + fr] = c2[j]; }
        LDS_WAIT();
        int e0 = 0, e1 = 0; float w0 = 0.f, w1 = 0.f; int lp0 = 0, lp1 = 0;
        if (lane < 16) {
            const int tok = tok0 + lane; const RsPart16 rsp{ssq2}; const float rstd = rsp(tok);
            float gl[4]; int gi = 0;
#pragma unroll
            for (int j = 0; j < 4; ++j) gl[j] = lg[lane * 40 + j] * rstd + F.in[23][j];
            float gm = gl[0];
#pragma unroll
            for (int j = 1; j < 4; ++j) if (gl[j] > gm) { gm = gl[j]; gi = j; }
            float gs = 0.f;
#pragma unroll
            for (int j = 0; j < 4; ++j) gs += __expf(gl[j] - gm);
            const float gp = 1.0f / gs;
            float el[8];
#pragma unroll
            for (int j = 0; j < 8; ++j) el[j] = lg[lane * 40 + 4 + gi * 8 + j] * rstd + F.in[25][gi * 8 + j];
            int i0 = 0; float m0 = el[0];
#pragma unroll
            for (int j = 1; j < 8; ++j) if (el[j] > m0) { m0 = el[j]; i0 = j; }
            int i1 = -1; float m1 = -3.0e38f;
#pragma unroll
            for (int j = 0; j < 8; ++j) if (j != i0 && el[j] > m1) { m1 = el[j]; i1 = j; }
            const float p1 = __expf(m1 - m0); const float inv = 1.0f / (1.0f + p1);
            e0 = gi * 8 + i0; e1 = gi * 8 + i1; w0 = gp * inv; w1 = gp * p1 * inv;
            lp0 = atomicAdd((int*)&lcnt[e0], 1); lp1 = atomicAdd((int*)&lcnt[e1], 1);
            slotw[2 * tok] = w0; slotw[2 * tok + 1] = w1;
        }
        __syncthreads();
        if (tid < 32) lbase[tid] = (int)atomicAdd(&gcnt[tid], (unsigned)lcnt[tid]);
        __syncthreads();
        if (lane < 16) { const int tok = tok0 + lane;
            list[(size_t)e0 * T + lbase[e0] + lp0] = 2 * tok; list[(size_t)e1 * T + lbase[e1] + lp1] = 2 * tok + 1; }
        __syncthreads();
    }
}

__device__ __forceinline__ int moe_tables(Frame& F, LAS int* pref) {
    const unsigned* gcnt = (const unsigned*)(F.ws + WS_CTL) + CW_CNT;
    if (F.tid == 0) { int acc = 0; for (int e = 0; e < NE; ++e) { pref[e] = acc; acc += ((int)__hip_atomic_load(gcnt + e, RLX_AGENT) + 255) >> 8; } pref[NE] = acc; }
    __syncthreads();
    return pref[NE];
}
__device__ __forceinline__ void moe_fill_tok(Frame& F, const MoeOrder& S, LAS int* ltok, const LAS int* pref) {
    const unsigned* gcnt = (const unsigned*)(F.ws + WS_CTL) + CW_CNT; const int* list = (const int*)(F.ws + WS_LIST);
    pg8::Unit u;
    for (int i = 0; i < 8 && S.next(i, u); ++i) {
        if (F.tid < 256) { const int e = u.aux, r = (u.pm - pref[e]) * 256 + F.tid; const int cnt = (int)__hip_atomic_load(gcnt + e, RLX_AGENT);
            ltok[i * 256 + F.tid] = (r < cnt) ? list[(size_t)e * T + r] : -1; }
    }
    __syncthreads();
}
struct GatherG2 : GatherG {
    __device__ __forceinline__ void a_voff(const pg8::Unit& u, const int (&R)[2], const int (&C)[2], unsigned (&v)[2][2], const LAS int* ltok) const {
#pragma unroll
        for (int h = 0; h < 2; ++h)
#pragma unroll
            for (int i = 0; i < 2; ++i) { int sl = ltok[(u.idx & 7) * 256 + h * 128 + R[i]]; sl = sl < 0 ? 0 : sl; v[h][i] = (unsigned)((sl >> 1) * lda + C[i]) * 2u; }
    }
};

__device__ __forceinline__ void p10_final(Frame& F) {
    const int gw = F.vcu * NWAVES + F.wave, NGW = F.G * NWAVES, lane = F.lane;
    const bf16* Y = (const bf16*)(F.ws + WS_YSLOT); const bf16* XB = (const bf16*)(F.ws + WS_XB); float* out = F.out; const f32x4* fw = (const f32x4*)F.in[29] + lane;
    for (int m = gw; m < T; m += NGW) {
        f32x4* xo = (f32x4*)(out + (size_t)m * DM) + lane; const u32x2* xr = (const u32x2*)(XB + (size_t)m * DM) + lane;
        const u32x2* y0 = (const u32x2*)(Y + (size_t)(2 * m) * DM) + lane; const u32x2* y1 = (const u32x2*)(Y + (size_t)(2 * m + 1) * DM) + lane;
        f32x4 v[4]; float s = 0.f;
#pragma unroll
        for (int j = 0; j < 4; ++j) { const u32x2 x = xr[64 * j], a = y0[64 * j], c = y1[64 * j];
            v[j].x = bflo(x.x) + (bflo(a.x) + bflo(c.x)); v[j].y = bfhi(x.x) + (bfhi(a.x) + bfhi(c.x)); v[j].z = bflo(x.y) + (bflo(a.y) + bflo(c.y)); v[j].w = bfhi(x.y) + (bfhi(a.y) + bfhi(c.y));
            s += (v[j].x * v[j].x + v[j].y * v[j].y) + (v[j].z * v[j].z + v[j].w * v[j].w); }
        const float rstd = 1.0f / sqrtf(wave_sum(s) * (1.0f / DM) + EPS);
#pragma unroll
        for (int j = 0; j < 4; ++j) { const f32x4 w = fw[64 * j]; xo[64 * j] = v[j] * rstd * w; }
    }
}

constexpr int N_PHASES = 12;
__global__ void __launch_bounds__(NTHR, 2) hymba_fwd(Args args) {
    extern __shared__ __attribute__((aligned(16))) unsigned char lds_raw[];
    Frame F;
    F.lds = (LAS unsigned char*)lds_raw;
    F.tid = threadIdx.x; F.lane = F.tid & 63; F.wave = __builtin_amdgcn_readfirstlane(F.tid >> 6);
    F.G = gridDim.x; { const int bx = blockIdx.x; F.vcu = (F.G % 8 == 0) ? (bx % 8) * (F.G / 8) + bx / 8 : bx; }
    F.in = args.in; F.ws = args.ws; F.out = args.out;
    unsigned char* ws = args.ws;
    volatile LAS unsigned* MISC = (volatile LAS unsigned*)(F.lds + LDS_MISC);
    LAS int* ltok = (LAS int*)(F.lds + LDS_TOK);
    LAS int* pref = (LAS int*)(F.lds + LDS_MISC + 256);
    if (F.tid < 64) MISC[F.tid] = 0u;
    __syncthreads();
    XcdBarrier bar; bar.bar = (unsigned*)(ws + WS_CTL) + CW_BAR; bar.x = 0; bar.st = nullptr;
    if (MK_N_LAUNCHES == 1) bar = xcd_barrier_post((unsigned*)(ws + WS_CTL) + CW_BAR, MISC + 8);
    const int lo = args.ph_lo, hi = args.ph_hi;
#ifndef PH_MASK
#define PH_MASK 0xfff
#endif
#define IN(k) (((PH_MASK >> (k)) & 1) && lo <= (k) && (k) < hi)
#define SEAM(k) do { if (IN(k) && IN((k) + 1)) xcd_barrier(bar); } while (0)
#ifndef PH_TWICE
#define PH_TWICE 0
#endif
#define REP(k)

    if (IN(0)) REP(0) { p0_prologue(F); } SEAM(0);
    if (IN(1)) REP(1) {
        { pg8::DenseG g{(const bf16*)(ws + WS_XB), (const bf16*)(ws + WS_WIN), DM, DM, DM / 64, 0}; pg8::StaticOrder S; S.init(T, DIN, F.G, (int)blockIdx.x);
          EpiBf16<RsArr> E{(bf16*)(ws + WS_PROJ), DIN, RsArr{(const float*)(ws + WS_RSTD1)}};
          pg8::gemm_phase<pg8::DenseG, EpiBf16<RsArr>, pg8::StaticOrder, true>(F.lds, ltok, g, S, E); }
        { pg8::DenseG g{(const bf16*)(ws + WS_MEMN), (const bf16*)(ws + WS_WKV), DM, DM, DM / 64, 0}; pg8::StaticOrder S; S.init(MT, 2048, F.G, (int)blockIdx.x);
          EpiBf16<RsNone> E{(bf16*)(ws + WS_KV), 2048, RsNone{}};
          pg8::gemm_phase<pg8::DenseG, EpiBf16<RsNone>, pg8::StaticOrder, true>(F.lds, ltok, g, S, E); }
    } SEAM(1);
    if (IN(2)) REP(2) { for (int it = blockIdx.x; it < 256; it += F.G) rnn_item(F, it); } SEAM(2);
    if (IN(3)) REP(3) { for (int it = blockIdx.x; it < BATCH * NCHUNK; it += F.G) { attn_item(F, it); __syncthreads(); } } SEAM(3);
    if (IN(4)) REP(4) {
        pg8::DenseG g{(const bf16*)(ws + WS_YMIX), (const bf16*)(ws + WS_WOUT), DM, DM, 8, 512}; pg8::TwoHalfOrder S; S.s.init(T, DM, F.G, (int)blockIdx.x);
        p3_scale_table(F, S.s, (LAS float*)(F.lds + LDS_TOK));
        EpiRes<true, false> E{F.in[0], (bf16*)(ws + WS_XB), (float*)(ws + WS_SSQ1), (const LAS float*)(F.lds + LDS_TOK)};
        pg8::gemm_phase<pg8::DenseG, EpiRes<true, false>, pg8::TwoHalfOrder, true>(F.lds, ltok, g, S, E);
    } SEAM(4);
    if (IN(5)) REP(5) {
        pg8::DenseG g{(const bf16*)(ws + WS_XB), (const bf16*)(ws + WS_WQ), DM, DM, DM / 64, 0}; pg8::StaticOrder S; S.init(T, DM, F.G, (int)blockIdx.x);
        EpiBf16<RsPart16> E{(bf16*)(ws + WS_QX), DM, RsPart16{(const float*)(ws + WS_SSQ1)}};
        pg8::gemm_phase<pg8::DenseG, EpiBf16<RsPart16>, pg8::StaticOrder, true>(F.lds, ltok, g, S, E);
    } SEAM(5);
    if (IN(6)) REP(6) { for (int it = blockIdx.x; it < BATCH * XH * (SEQ / 256); it += F.G) xattn_item(F, it); } SEAM(6);
    if (IN(7)) REP(7) {
        pg8::DenseG g{(const bf16*)(ws + WS_O), (const bf16*)(ws + WS_WO), DM, DM, DM / 64, 0}; pg8::StaticOrder S; S.init(T, DM, F.G, (int)blockIdx.x);
        EpiRes<false, true> E{nullptr, (bf16*)(ws + WS_XB), (float*)(ws + WS_SSQ2), (const LAS float*)(F.lds + LDS_TOK)};
        pg8::gemm_phase<pg8::DenseG, EpiRes<false, true>, pg8::StaticOrder, true>(F.lds, ltok, g, S, E);
    } SEAM(7);
    if (IN(8)) REP(8) { p7_router(F); } SEAM(8);
    if (IN(9)) REP(9) {
        const int ntile = moe_tables(F, pref);
        MoeOrder S{pref, F.G, (int)blockIdx.x, ntile};
        moe_fill_tok(F, S, ltok, pref);
        GatherG2 g; g.A = (const bf16*)(ws + WS_XB); g.Bt = (const bf16*)(ws + WS_WGU); g.lda = DM; g.ldb = DM; g.nt = DM / 64;
        EpiGateUp E{(bf16*)(ws + WS_HID), ltok, RsPart16{(const float*)(ws + WS_SSQ2)}};
        pg8::gemm_phase<GatherG2, EpiGateUp, MoeOrder, true>(F.lds, ltok, g, S, E);
    } SEAM(9);
    if (IN(10)) REP(10) {
        const int ntile = moe_tables(F, pref);
        MoeOrder S{pref, F.G, (int)blockIdx.x, ntile};
        moe_fill_tok(F, S, ltok, pref);
        DownG g{(const bf16*)(ws + WS_HID), (const bf16*)(ws + WS_WD), DE, DE, DE / 64};
        EpiDown E{(bf16*)(ws + WS_YSLOT), (const float*)(ws + WS_SLOTW), ltok};
        pg8::gemm_phase<DownG, EpiDown, MoeOrder, true>(F.lds, ltok, g, S, E);
    } SEAM(10);
    if (IN(11)) REP(11) { p10_final(F); }
#undef IN
#undef SEAM
}

extern "C" void kernel_launch(void* const* d_in, const int* in_sizes, int n_in, void* d_out, int out_size, void* d_ws, size_t ws_size, hipStream_t stream) {
    static int grid = 0;
    if (grid == 0) {
        if (n_in != 30 || in_sizes[0] != T * DM || out_size != T * DM || ws_size < WS_END) {
            fprintf(stderr, "kernel_launch: unexpected shapes: n_in %d in0 %d out %d ws %zu (need %zu)\n", n_in, n_in > 0 ? in_sizes[0] : -1, out_size, ws_size, (size_t)WS_END); grid = -1; return; }
        int dev = 0, cus = 0, per_cu = 0;
        if (hipGetDevice(&dev) != hipSuccess || hipDeviceGetAttribute(&cus, hipDeviceAttributeMultiprocessorCount, dev) != hipSuccess) { grid = -1; return; }
        if (hipFuncSetAttribute((const void*)hymba_fwd, hipFuncAttributeMaxDynamicSharedMemorySize, LDS_BYTES) != hipSuccess) { fprintf(stderr, "kernel_launch: hipFuncSetAttribute failed\n"); grid = -1; return; }
        if (hipOccupancyMaxActiveBlocksPerMultiprocessor(&per_cu, (const void*)hymba_fwd, NTHR, LDS_BYTES) != hipSuccess || per_cu < 1) { fprintf(stderr, "kernel_launch: occupancy query failed (%d)\n", per_cu); (void)hipGetLastError(); grid = -1; return; }
        grid = cus;
    }
    if (grid < 0) return;
    (void)hipMemsetAsync((char*)d_ws + WS_CTL, 0, CTL_ZERO_BYTES, stream);
    Args a{};
    for (int i = 0; i < 30; ++i) a.in[i] = (const float*)d_in[i];
    a.out = (float*)d_out; a.ws = (unsigned char*)d_ws;
    if (MK_N_LAUNCHES == 1) {
        a.ph_lo = 0; a.ph_hi = N_PHASES;
        void* kargs[] = {&a};
        hipError_t e = hipLaunchCooperativeKernel((const void*)hymba_fwd, dim3(grid), dim3(NTHR), kargs, LDS_BYTES, stream);
        if (e != hipSuccess) fprintf(stderr, "cooperative launch failed: %s (grid %d)\n", hipGetErrorString(e), grid);
    } else {
        for (int p = 0; p < N_PHASES; ++p) { a.ph_lo = p; a.ph_hi = p + 1;
            for (int rep = 0; rep < ((p == PH_DUP) ? 2 : 1); ++rep) hipLaunchKernelGGL(hymba_fwd, dim3(grid), dim3(NTHR), LDS_BYTES, stream, a); }
    }
}
```

```cpp
#include <hip/hip_runtime.h>
#include <cstdio>
#include <cstdint>

#ifndef PH_DUP
#define PH_DUP -1
#endif
#ifndef MK_N_LAUNCHES
#define MK_N_LAUNCHES 1
#endif

#define LAS __attribute__((address_space(3)))
#define GAS __attribute__((address_space(1)))
typedef unsigned short bf16;
typedef short bf16x8 __attribute__((ext_vector_type(8)));
typedef short s16x4 __attribute__((ext_vector_type(4)));
typedef float f32x4 __attribute__((ext_vector_type(4)));
typedef float f32x16 __attribute__((ext_vector_type(16)));
typedef unsigned u32x4 __attribute__((ext_vector_type(4)));
typedef unsigned u32x2 __attribute__((ext_vector_type(2)));
typedef GAS unsigned gu32;

constexpr int BATCH = 8, SEQ = 4096, DM = 1024, T = BATCH * SEQ;
constexpr int NMEM = 256, MT = BATCH * NMEM;
constexpr int DRNN = 512, DATT = 512, NH = 8, HD = 64, CHUNK = 64, NCHUNK = SEQ / CHUNK, LEFT = 8;
constexpr int DIN = 2 * DRNN + 3 * DATT;
constexpr int XH = 4, XD = 256;
constexpr int NE = 32, DE = 512, NGRP = 4, EPG = 8;
constexpr float EPS = 1e-6f;
constexpr int NWAVES = 8, NTHR = 512;

constexpr size_t MiB = 1u << 20;
constexpr size_t WS_CTL = 0, CTL_ZERO_BYTES = 1 * MiB;
constexpr size_t WS_RSTD1 = 1 * MiB;
constexpr size_t WS_SSQR = 2 * MiB;
constexpr size_t WS_SSQA = 6 * MiB;
constexpr size_t WS_SSQ1 = 7 * MiB;
constexpr size_t WS_SSQ2 = 9 * MiB;
constexpr size_t WS_SLOTW = 11 * MiB;
constexpr size_t WS_LIST = 12 * MiB;
constexpr size_t WS_WIN = 16 * MiB;
constexpr size_t WS_WKV = 21 * MiB;
constexpr size_t WS_WOUT = 25 * MiB;
constexpr size_t WS_WQ = 27 * MiB;
constexpr size_t WS_WO = 29 * MiB;
constexpr size_t WS_WR = 31 * MiB;
constexpr size_t WS_WGU = 32 * MiB;
constexpr size_t WS_WD = 96 * MiB;
constexpr size_t WS_XB = 128 * MiB;
constexpr size_t WS_PROJ = 192 * MiB;
constexpr size_t WS_X1 = 192 * MiB;
constexpr size_t WS_YSLOT = 192 * MiB;
constexpr size_t WS_HID = 320 * MiB;
constexpr size_t WS_YMIX = 352 * MiB;
constexpr size_t WS_QX = 352 * MiB;
constexpr size_t WS_MEMN = 416 * MiB;
constexpr size_t WS_O = 416 * MiB;
constexpr size_t WS_KV = 480 * MiB;
constexpr size_t WS_END = 488 * MiB;
constexpr int HID_ROWS = 2 * T + NE * 256;

constexpr int CW_CNT = 64;
constexpr int CW_BAR = 4096;

constexpr int RING_BYTES = 131072;
constexpr int LDS_TOK = RING_BYTES;
constexpr int LDS_MISC = RING_BYTES + 8192;
constexpr int LDS_BYTES = 147456;

#define RLX_AGENT __ATOMIC_RELAXED, __HIP_MEMORY_SCOPE_AGENT
#define LDS_WAIT() asm volatile("s_waitcnt lgkmcnt(0)" ::: "memory")
#define VM_WAIT() asm volatile("s_waitcnt vmcnt(0)" ::: "memory")

__device__ __forceinline__ unsigned f2bf(float f) { unsigned u = __builtin_bit_cast(unsigned, f); return (u + 0x7fffu + ((u >> 16) & 1u)) >> 16; }
__device__ __forceinline__ unsigned pk2(float lo, float hi) { return f2bf(lo) | (f2bf(hi) << 16); }
__device__ __forceinline__ float bf2f(unsigned short b) { return __builtin_bit_cast(float, (unsigned)b << 16); }
__device__ __forceinline__ float bflo(unsigned w) { return __builtin_bit_cast(float, w << 16); }
__device__ __forceinline__ float bfhi(unsigned w) { return __builtin_bit_cast(float, w & 0xffff0000u); }

namespace pg8 {
constexpr int BM = 256, BK = 64, HALF = 128, HTB = HALF * BK * 2, STAGE_BYTES = 8 * HTB, NXCD = 8, WGM = 8;
__host__ __device__ __forceinline__ int lds_byte(int r, int c) { const int st = (r >> 4) * 2 + (c >> 5), rr = r & 15, cc = c & 31, ob = rr * 64 + cc * 2; return st * 1024 + (ob ^ (((ob >> 9) & 1) << 5)); }
__host__ __device__ __forceinline__ void stage_rc(int b, int& R, int& C) { const int st = b / 1024, sb = b % 1024, swz = sb ^ (((sb >> 9) & 1) << 5); R = (st >> 1) * 16 + swz / 64; C = (st & 1) * 32 + (swz % 64) / 2; }
__host__ __device__ __forceinline__ int perm32(int rho) { const int n = rho >> 4, i = rho & 15; return 8 * (i >> 2) + 4 * n + (i & 3); }

struct Unit { int pm, pn, aux, idx; };

struct StaticOrder {
    int nM, nN, nwg, G, c;
    __device__ void init(int M, int N, int G_, int c_) { nM = M / BM; nN = N / BM; nwg = nM * nN; G = G_; c = c_; }
    __device__ bool next(int i, Unit& u) const {
        const long L = (long)i * G + c; if (L >= nwg) return false;
        int wgid = (int)L; { const int q = nwg / NXCD, r = nwg % NXCD, xcd = wgid % NXCD, off = wgid / NXCD; wgid = (xcd < r ? xcd * (q + 1) : r * (q + 1) + (xcd - r) * q) + off; }
        const int nig = WGM * nN, gid = wgid / nig, fm = gid * WGM, gsz = (nM - fm) < WGM ? (nM - fm) : WGM;
        u.pm = fm + ((wgid % nig) % gsz); u.pn = (wgid % nig) / gsz; u.aux = 0; u.idx = i; return true;
    }
};
struct TwoHalfOrder {
    StaticOrder s;
    __device__ bool next(int i, Unit& u) const { if (!s.next(i >> 1, u)) return false; u.aux = i & 1; u.idx = i; return true; }
};

__device__ __forceinline__ unsigned cvt_pk_bf16(float lo, float hi) { unsigned r; asm volatile("v_cvt_pk_bf16_f32 %0, %1, %2" : "=v"(r) : "v"(lo), "v"(hi)); return r; }

struct DenseG {
    const bf16* A; const bf16* Bt; int lda, ldb, nt, kaux;
    static constexpr bool GATHER = false;
    __device__ __forceinline__ const char* a_base(const Unit& u) const { return (const char*)(A + (size_t)u.pm * BM * lda + (size_t)u.aux * kaux); }
    __device__ __forceinline__ const char* b_base(const Unit& u) const { return (const char*)(Bt + (size_t)u.pn * BM * ldb + (size_t)u.aux * kaux); }
    __device__ __forceinline__ void a_voff(const Unit&, const int (&R)[2], const int (&C)[2], unsigned (&v)[2][2], const LAS int*) const {
#pragma unroll
        for (int h = 0; h < 2; ++h)
#pragma unroll
            for (int i = 0; i < 2; ++i) v[h][i] = (unsigned)((h * HALF + R[i]) * lda + C[i]) * 2u;
    }
};

template <class G, class Epi, class Sched, bool ALIGN_EPI>
__device__ __forceinline__ void gemm_phase(LAS unsigned char* lds, const LAS int* ltok, const G& g, const Sched& S, const Epi& E) {
    const int tid = threadIdx.x, wid = __builtin_amdgcn_readfirstlane(tid >> 6), lane = tid & 63, wr = wid >> 2, wc = wid & 3, fr = lane & 15, fq = lane >> 4;
    const int nt = g.nt;
    int Rs[2], Cs[2]; unsigned voffB[2];
#pragma unroll
    for (int i = 0; i < 2; ++i) { stage_rc(tid * 16 + i * 8192, Rs[i], Cs[i]); const int Rb = Epi::PERM ? ((Rs[i] & ~31) + perm32(Rs[i] & 31)) : Rs[i];
        voffB[i] = (unsigned)(Rb * g.ldb + Cs[i]) * 2u; }
    const size_t kstep = (size_t)(BK * 2);
    const size_t hstepB = (size_t)HALF * g.ldb * 2;
    const unsigned ldsw = (unsigned)wid * 1024u;
    const int aoff = lds_byte(wr * 64 + fr, fq * 8), boff = lds_byte(wc * 32 + fr, fq * 8);
#define PG8_SA(b, h) (((b) * 2 + (h)) * HTB)
#define PG8_SB(b, h) ((4 + (b) * 2 + (h)) * HTB)
#define PG8_STAGE_A(bufoff, gbase, VO, h) do { _Pragma("unroll") for (int _i = 0; _i < 2; ++_i) \
        __builtin_amdgcn_global_load_lds((const unsigned*)((const char*)(gbase) + (VO)[h][_i]), (LAS unsigned*)(lds + (bufoff) + ldsw + _i * 8192), 16, 0, 0); } while (0)
#define PG8_STAGE_B(bufoff, gbase) do { _Pragma("unroll") for (int _i = 0; _i < 2; ++_i) \
        __builtin_amdgcn_global_load_lds((const unsigned*)((const char*)(gbase) + voffB[_i]), (LAS unsigned*)(lds + (bufoff) + ldsw + _i * 8192), 16, 0, 0); } while (0)
#define PG8_LDA(dst, b, h) do { _Pragma("unroll") for (int m = 0; m < 4; ++m) _Pragma("unroll") for (int k = 0; k < 2; ++k) dst[m][k] = *(const LAS bf16x8*)(lds + PG8_SA(b, h) + aoff + m * 2048 + k * 1024); } while (0)
#define PG8_LDB(dst, b, h) do { _Pragma("unroll") for (int n = 0; n < 2; ++n) _Pragma("unroll") for (int k = 0; k < 2; ++k) dst[n][k] = *(const LAS bf16x8*)(lds + PG8_SB(b, h) + boff + n * 2048 + k * 1024); } while (0)
#define PG8_MMA(ai, bj, At, Bt) do { __builtin_amdgcn_s_setprio(1); _Pragma("unroll") for (int m = 0; m < 4; ++m) _Pragma("unroll") for (int n = 0; n < 2; ++n) _Pragma("unroll") for (int k = 0; k < 2; ++k) \
        acc[ai][bj][m][n] = __builtin_amdgcn_mfma_f32_16x16x32_bf16(Bt[n][k], At[m][k], acc[ai][bj][m][n], 0, 0, 0); __builtin_amdgcn_s_setprio(0); } while (0)
#define PG8_WAIT_V(n) asm volatile("s_waitcnt vmcnt(" #n ")" ::: "memory")
#define PG8_WAIT_L(n) asm volatile("s_waitcnt lgkmcnt(" #n ")" ::: "memory")
#define PG8_BAR __builtin_amdgcn_s_barrier()
#define PG8_SCHED __builtin_amdgcn_sched_barrier(0)
    Unit cur, nxt; int ui = 0;
    if (!S.next(0, cur)) return;
    f32x4 acc[2][2][4][2];
#pragma unroll
    for (int a = 0; a < 2; ++a)
#pragma unroll
        for (int b = 0; b < 2; ++b)
#pragma unroll
            for (int m = 0; m < 4; ++m)
#pragma unroll
                for (int n = 0; n < 2; ++n) acc[a][b][m][n] = (f32x4){0.f, 0.f, 0.f, 0.f};
    bf16x8 At[4][2], B0[2][2], B1[2][2];
    unsigned voAc[2][2], voAn[2][2];
    g.a_voff(cur, Rs, Cs, voAc, ltok);
    const char* cA = g.a_base(cur); const char* cB = g.b_base(cur);
    PG8_STAGE_B(PG8_SB(0, 0), cB); PG8_STAGE_B(PG8_SB(0, 1), cB + hstepB); PG8_STAGE_A(PG8_SA(0, 0), cA, voAc, 0); PG8_STAGE_A(PG8_SA(0, 1), cA, voAc, 1);
    if (wr == 1) PG8_BAR;
    PG8_WAIT_V(2); PG8_BAR;
    PG8_STAGE_B(PG8_SB(1, 0), cB + kstep); PG8_STAGE_A(PG8_SA(1, 0), cA + kstep, voAc, 0); PG8_STAGE_B(PG8_SB(1, 1), cB + hstepB + kstep);
    PG8_WAIT_V(6); PG8_BAR;
    for (;;) {
        const bool has_next = S.next(ui + 1, nxt);
        const char* nA = cA; const char* nB = cB;
        if (has_next) { nA = g.a_base(nxt); nB = g.b_base(nxt); g.a_voff(nxt, Rs, Cs, voAn, ltok); }
        else {
#pragma unroll
            for (int h = 0; h < 2; ++h)
#pragma unroll
                for (int i = 0; i < 2; ++i) voAn[h][i] = voAc[h][i]; }
        for (int t = 0; t < nt; t += 2) {
            const bool last = (t == nt - 2);
            const char* a1 = cA + (size_t)(t + 1) * kstep;
            const char* a2 = last ? nA : cA + (size_t)(t + 2) * kstep; const char* b2 = last ? nB : cB + (size_t)(t + 2) * kstep;
            const char* a3 = a2 + kstep; const char* b3 = b2 + kstep;
            unsigned vo2[2][2];
#pragma unroll
            for (int h = 0; h < 2; ++h)
#pragma unroll
                for (int i = 0; i < 2; ++i) vo2[h][i] = last ? voAn[h][i] : voAc[h][i];
            PG8_LDB(B0, 0, 0); PG8_LDB(B1, 0, 1); PG8_SCHED; PG8_LDA(At, 0, 0); PG8_STAGE_A(PG8_SA(1, 1), a1, voAc, 1);
            PG8_WAIT_V(8); PG8_WAIT_L(0); PG8_BAR; PG8_MMA(0, 0, At, B0); PG8_MMA(0, 1, At, B1); PG8_BAR; PG8_SCHED;
            PG8_LDA(At, 0, 1); PG8_STAGE_B(PG8_SB(0, 0), b2); PG8_STAGE_B(PG8_SB(0, 1), b2 + hstepB); PG8_STAGE_A(PG8_SA(0, 0), a2, vo2, 0);
            PG8_WAIT_V(8); PG8_WAIT_L(0); PG8_BAR; PG8_MMA(1, 0, At, B0); PG8_MMA(1, 1, At, B1); PG8_BAR; PG8_SCHED;
            PG8_LDB(B0, 1, 0); PG8_LDB(B1, 1, 1); PG8_SCHED; PG8_LDA(At, 1, 0); PG8_STAGE_A(PG8_SA(0, 1), a2, vo2, 1);
            PG8_WAIT_V(8); PG8_WAIT_L(0); PG8_BAR; PG8_MMA(0, 0, At, B0); PG8_MMA(0, 1, At, B1); PG8_BAR; PG8_SCHED;
            PG8_LDA(At, 1, 1); PG8_STAGE_B(PG8_SB(1, 0), b3); PG8_STAGE_B(PG8_SB(1, 1), b3 + hstepB); PG8_STAGE_A(PG8_SA(1, 0), a3, vo2, 0);
            PG8_WAIT_V(8); PG8_WAIT_L(0); PG8_BAR; PG8_MMA(1, 0, At, B0); PG8_MMA(1, 1, At, B1); PG8_BAR; PG8_SCHED;
        }
        if constexpr (ALIGN_EPI) { if (wr == 0) PG8_BAR; }
        const bool keep = E(acc, cur, wr, wc, fr, fq);
        if (!has_next) break;
        if (!keep) {
#pragma unroll
            for (int a = 0; a < 2; ++a)
#pragma unroll
                for (int b = 0; b < 2; ++b)
#pragma unroll
                    for (int m = 0; m < 4; ++m)
#pragma unroll
                        for (int n = 0; n < 2; ++n) acc[a][b][m][n] = (f32x4){0.f, 0.f, 0.f, 0.f};
        }
        cur = nxt; cA = nA; cB = nB; ++ui;
#pragma unroll
        for (int h = 0; h < 2; ++h)
#pragma unroll
            for (int i = 0; i < 2; ++i) voAc[h][i] = voAn[h][i];
        if constexpr (ALIGN_EPI) { if (wr == 1) PG8_BAR; }
    }
    PG8_WAIT_V(0);
    if constexpr (!ALIGN_EPI) { if (wr == 0) PG8_BAR; }
    PG8_BAR;
#undef PG8_SA
#undef PG8_SB
#undef PG8_STAGE_A
#undef PG8_STAGE_B
#undef PG8_LDA
#undef PG8_LDB
#undef PG8_MMA
#undef PG8_WAIT_V
#undef PG8_WAIT_L
#undef PG8_BAR
#undef PG8_SCHED
}
}

#define XB_TMO      128
#define XB_XCNT(j)  (256  + 64 * (j))
#define XB_XSUB(j)  (1280 + 64 * (j))
#define XB_XGEN(j)  (2304 + 64 * (j))
#define XB_TOP      3328
#define XB_TOPGEN   3392
#define XCD_BAR_WORDS 3456
#define XB_SPIN_CAP (1u << 18)
__device__ __forceinline__ unsigned xb_ld(unsigned* p)              { return __hip_atomic_load(p, __ATOMIC_RELAXED, __HIP_MEMORY_SCOPE_AGENT); }
__device__ __forceinline__ unsigned xb_add(unsigned* p, unsigned v) { return __hip_atomic_fetch_add(p, v, __ATOMIC_RELAXED, __HIP_MEMORY_SCOPE_AGENT); }
__device__ __forceinline__ unsigned xb_xcc_id() { return (unsigned)__builtin_amdgcn_s_getreg((3 << 11) | 20) & 0xFu; }
#define XB_SPIN(cond, bar) do { unsigned _sp = 0; while (cond) { __builtin_amdgcn_s_sleep(1); \
    if ((++_sp & 255u) == 0u) { if (xb_ld(&(bar)[XB_TMO])) break; if (_sp > XB_SPIN_CAP) { atomicAdd(&(bar)[XB_TMO], 1u); break; } } } } while (0)
struct XcdBarrier { unsigned* bar; unsigned x; volatile LAS unsigned* st; };
__device__ __forceinline__ XcdBarrier xcd_barrier_post(unsigned* bar, volatile LAS unsigned* st) {
    XcdBarrier b; b.bar = bar; b.x = xb_xcc_id(); b.st = st;
    if (threadIdx.x == 0) (void)xb_add(&bar[XB_XCNT(b.x)], 1u);
    return b;
}
__device__ __forceinline__ void xcd_barrier_complete(unsigned* bar, unsigned x, unsigned& nloc, unsigned& nx) {
    const unsigned G = gridDim.x * gridDim.y * gridDim.z;
    unsigned sum, cnt, mine, sp = 0u;
    for (;;) {
        sum = 0u; cnt = 0u; mine = 0u;
#pragma unroll
        for (unsigned j = 0; j < 16; ++j) { const unsigned c = xb_ld(&bar[XB_XCNT(j)]); sum += c; cnt += (c > 0u) ? 1u : 0u; mine = (j == x) ? c : mine; }
        if (sum == G) break;
        __builtin_amdgcn_s_sleep(1);
        if ((++sp & 255u) == 0u) { if (xb_ld(&bar[XB_TMO])) break; if (sp > XB_SPIN_CAP) { atomicAdd(&bar[XB_TMO], 1u); break; } }
    }
    nloc = mine > 0u ? mine : 1u; nx = cnt > 0u ? cnt : 1u;
}
__device__ __forceinline__ void xcd_barrier(const XcdBarrier& b) {
    asm volatile("s_waitcnt vmcnt(0)" ::: "memory");
    __syncthreads();
    if (threadIdx.x == 0) {
        unsigned* bar = b.bar;
        __builtin_amdgcn_s_waitcnt(0);
        unsigned nloc = b.st[0], nx = b.st[1];
        if (nloc == 0u) { xcd_barrier_complete(bar, b.x, nloc, nx); b.st[0] = nloc; b.st[1] = nx; }
        const unsigned old = xb_add(&bar[XB_XSUB(b.x)], 1u);
        const unsigned gen = old / nloc;
        if (old + 1u == (gen + 1u) * nloc) {
            __builtin_amdgcn_fence(__ATOMIC_RELEASE, "agent");
            asm volatile("s_waitcnt vmcnt(0)" ::: "memory");
            const unsigned og = xb_add(&bar[XB_TOP], 1u);
            const unsigned tg = og / nx;
            if (og + 1u == (tg + 1u) * nx) xb_add(&bar[XB_TOPGEN], 1u);
            else XB_SPIN(xb_ld(&bar[XB_TOPGEN]) == tg, bar);
            __builtin_amdgcn_fence(__ATOMIC_ACQUIRE, "agent");
            xb_add(&bar[XB_XGEN(b.x)], 1u);
            asm volatile("s_waitcnt vmcnt(0)" ::: "memory");
        } else {
            XB_SPIN(xb_ld(&bar[XB_XGEN(b.x)]) == gen, bar);
            __builtin_amdgcn_fence(__ATOMIC_ACQUIRE, "agent");
            asm volatile("s_waitcnt vmcnt(0)" ::: "memory");
        }
    }
    __syncthreads();
}

struct Args { const float* in[30]; float* out; unsigned char* ws; int ph_lo, ph_hi; };
struct Frame {
    LAS unsigned char* lds;
    int tid, lane, wave, vcu, G;
    const float* const* in;
    unsigned char* ws; float* out;
};
__device__ __forceinline__ float wave_sum(float v) {
#pragma unroll
    for (int o = 1; o < 64; o <<= 1) v += __shfl_xor(v, o);
    return v;
}

__device__ __forceinline__ void p0_tr_item(const float* W, int N, int k0, int n0, const float* sk, float cs, bf16* WT, int ldt, int drow0, LAS unsigned char* scr, int lane) {
    const int n4 = lane & 15, kq = lane >> 4;
    f32x4 v[16];
#pragma unroll
    for (int i = 0; i < 16; ++i) v[i] = *(const f32x4*)(W + (size_t)(k0 + kq + 4 * i) * N + n0 + 4 * n4);
#pragma unroll
    for (int i = 0; i < 16; ++i) { const float sc = (sk ? sk[k0 + kq + 4 * i] : 1.0f) * cs; u32x2 w; w.x = pk2(v[i].x * sc, v[i].y * sc); w.y = pk2(v[i].z * sc, v[i].w * sc);
        *(LAS u32x2*)(scr + (kq + 4 * i) * 128 + n4 * 8) = w; }
    LDS_WAIT(); asm volatile("" ::: "memory");
    const int g = lane >> 4, li = lane & 15;
    const LAS unsigned char* rp = scr + (li >> 2) * 128 + (16 * g + 4 * (li & 3)) * 2;
    bf16* op = WT + (size_t)(drow0 + 16 * g + li) * ldt + k0;
#pragma unroll
    for (int c = 0; c < 8; ++c) {
        const s16x4 a = __builtin_bit_cast(s16x4, __builtin_amdgcn_ds_read_tr16_b64_v4i16((LAS s16x4*)(rp + (8 * c) * 128)));
        const s16x4 b = __builtin_bit_cast(s16x4, __builtin_amdgcn_ds_read_tr16_b64_v4i16((LAS s16x4*)(rp + (8 * c + 4) * 128)));
        *(bf16x8*)(op + 8 * c) = (bf16x8){a[0], a[1], a[2], a[3], b[0], b[1], b[2], b[3]};
    }
    LDS_WAIT(); asm volatile("" ::: "memory");
}
__device__ __forceinline__ void p0_prologue(Frame& F) {
    LAS unsigned char* scr = F.lds + F.wave * 8192;
    const int gw = F.vcu * NWAVES + F.wave, NGW = F.G * NWAVES, lane = F.lane;
    unsigned char* ws = F.ws;
    bf16* WinT = (bf16*)(ws + WS_WIN); bf16* WkvT = (bf16*)(ws + WS_WKV); bf16* WoutT = (bf16*)(ws + WS_WOUT); bf16* WqT = (bf16*)(ws + WS_WQ);
    bf16* WoT = (bf16*)(ws + WS_WO); bf16* WguT = (bf16*)(ws + WS_WGU); bf16* WdT = (bf16*)(ws + WS_WD);
    constexpr int I_IN = 16 * 40, I_SQ = 16 * 16, I_GU = NE * 16 * 8, I_D = NE * 8 * 16;
    constexpr int NITEMS = I_IN + 5 * I_SQ + 2 * I_GU + I_D;
    for (int it = gw; it < NITEMS; it += NGW) {
        int r = it;
        if (r < I_IN) { const int kb = r / 40, nb = r % 40, n0 = nb * 64; const float cs = (n0 >= 1024 && n0 < 1536) ? 0.125f : 1.0f;
            p0_tr_item(F.in[3], DIN, kb * 64, n0, F.in[2], cs, WinT, DM, n0, scr, lane); continue; } r -= I_IN;
        if (r < I_SQ) { const int kb = r / 16, nb = r % 16; const float* sk = (kb < 8) ? F.in[12] : (F.in[13] - 512);
            p0_tr_item(F.in[14], DM, kb * 64, nb * 64, sk, 1.0f, WoutT, DM, nb * 64, scr, lane); continue; } r -= I_SQ;
        if (r < I_SQ) { const int kb = r / 16, nb = r % 16; p0_tr_item(F.in[17], DM, kb * 64, nb * 64, F.in[15], 0.0625f, WqT, DM, nb * 64, scr, lane); continue; } r -= I_SQ;
        if (r < I_SQ) { const int kb = r / 16, nb = r % 16; p0_tr_item(F.in[18], DM, kb * 64, nb * 64, nullptr, 1.0f, WkvT, DM, nb * 64, scr, lane); continue; } r -= I_SQ;
        if (r < I_SQ) { const int kb = r / 16, nb = r % 16; p0_tr_item(F.in[19], DM, kb * 64, nb * 64, nullptr, 1.0f, WkvT, DM, 1024 + nb * 64, scr, lane); continue; } r -= I_SQ;
        if (r < I_SQ) { const int kb = r / 16, nb = r % 16; p0_tr_item(F.in[20], DM, kb * 64, nb * 64, nullptr, 1.0f, WoT, DM, nb * 64, scr, lane); continue; } r -= I_SQ;
        if (r < 2 * I_GU) { const int up = r / I_GU; r -= up * I_GU; const int e = r / 128, q = r % 128, kb = q / 8, nb = q % 8, n0 = nb * 64;
            const int drow = (n0 >> 7) * 256 + up * 128 + (n0 & 127);
            p0_tr_item(F.in[26 + up] + (size_t)e * DM * DE, DE, kb * 64, n0, F.in[21], 1.0f, WguT + (size_t)e * 1024 * 1024, DM, drow, scr, lane); continue; } r -= 2 * I_GU;
        { const int e = r / 128, q = r % 128, kb = q / 16, nb = q % 16;
            p0_tr_item(F.in[28] + (size_t)e * DE * DM, DM, kb * 64, nb * 64, nullptr, 1.0f, WdT + (size_t)e * 1024 * 512, DE, nb * 64, scr, lane); }
    }
    bf16* XB = (bf16*)(ws + WS_XB); float* rstd1 = (float*)(ws + WS_RSTD1); bf16* MEMN = (bf16*)(ws + WS_MEMN);
    f32x4 nx[4];
    {
        const int m = gw;
        if (m < T + MT) { const f32x4* xr = (const f32x4*)((m < T ? F.in[0] : F.in[1]) + (size_t)(m < T ? m : m - T) * DM) + lane;
#pragma unroll
            for (int j = 0; j < 4; ++j) nx[j] = xr[64 * j]; }
    }
    for (int m = gw; m < T + MT; m += NGW) {
        const bool isx = m < T; const int row = isx ? m : m - T;
        f32x4 v[4]; float s = 0.f;
#pragma unroll
        for (int j = 0; j < 4; ++j) v[j] = nx[j];
        const int m2 = m + NGW;
        if (m2 < T + MT) { const f32x4* xr = (const f32x4*)((m2 < T ? F.in[0] : F.in[1]) + (size_t)(m2 < T ? m2 : m2 - T) * DM) + lane;
#pragma unroll
            for (int j = 0; j < 4; ++j) nx[j] = xr[64 * j]; }
#pragma unroll
        for (int j = 0; j < 4; ++j) s += (v[j].x * v[j].x + v[j].y * v[j].y) + (v[j].z * v[j].z + v[j].w * v[j].w);
        const float rstd = 1.0f / sqrtf(wave_sum(s) * (1.0f / DM) + EPS);
        unsigned long long* o8 = (unsigned long long*)((isx ? XB : MEMN) + (size_t)row * DM) + lane;
        if (isx) { if (lane == 0) rstd1[row] = rstd;
#pragma unroll
            for (int j = 0; j < 4; ++j) o8[64 * j] = (unsigned long long)pk2(v[j].x, v[j].y) | ((unsigned long long)pk2(v[j].z, v[j].w) << 32);
        } else { const f32x4* wv = (const f32x4*)F.in[16] + lane;
#pragma unroll
            for (int j = 0; j < 4; ++j) { const f32x4 w = wv[64 * j]; o8[64 * j] = (unsigned long long)pk2(v[j].x * rstd * w.x, v[j].y * rstd * w.y) | ((unsigned long long)pk2(v[j].z * rstd * w.z, v[j].w * rstd * w.w) << 32); }
        }
    }
    bf16* WrT = (bf16*)(ws + WS_WR);
    for (int i = (F.vcu * NTHR + F.tid); i < 64 * DM; i += F.G * NTHR) {
        const int n = i / DM, k = i % DM; float v = 0.f;
        if (n < 4) v = F.in[22][k * 4 + n]; else if (n < 36) { const int gg = (n - 4) >> 3, e = (n - 4) & 7; v = F.in[24][((size_t)gg * DM + k) * 8 + e]; }
        WrT[i] = (bf16)f2bf(v * F.in[21][k]);
    }
}

struct RsNone { __device__ __forceinline__ float operator()(int) const { return 1.0f; } };
struct RsArr { const float* p; __device__ __forceinline__ float operator()(int r) const { return p[r]; } };
struct RsPart16 { const float* p; __device__ __forceinline__ float operator()(int r) const { const f32x4* q = (const f32x4*)(p + (size_t)r * 16); const f32x4 a = q[0], b = q[1], c = q[2], d = q[3];
    const float s = ((a.x + a.y) + (a.z + a.w)) + ((b.x + b.y) + (b.z + b.w)) + ((c.x + c.y) + (c.z + c.w)) + ((d.x + d.y) + (d.z + d.w)); return 1.0f / sqrtf(s * (1.0f / DM) + EPS); } };

template <class RS> struct EpiBf16 {
    static constexpr bool PERM = true;
    bf16* O; int ldc; RS rs;
    __device__ __forceinline__ bool operator()(f32x4 (&acc)[2][2][4][2], const pg8::Unit& u, int wr, int wc, int fr, int fq) const {
        const int row0 = u.pm * 256 + wr * 64 + fr, col0 = u.pn * 256 + wc * 32 + 8 * fq;
#pragma unroll
        for (int ai = 0; ai < 2; ++ai)
#pragma unroll
            for (int m = 0; m < 4; ++m) { const int row = row0 + ai * 128 + m * 16; const float s = rs(row); bf16* rowp = O + (size_t)row * ldc + col0;
#pragma unroll
                for (int bj = 0; bj < 2; ++bj) { const f32x4 v0 = acc[ai][bj][m][0] * s, v1 = acc[ai][bj][m][1] * s; u32x4 w;
                    w.x = pg8::cvt_pk_bf16(v0[0], v0[1]); w.y = pg8::cvt_pk_bf16(v0[2], v0[3]); w.z = pg8::cvt_pk_bf16(v1[0], v1[1]); w.w = pg8::cvt_pk_bf16(v1[2], v1[3]);
                    *(u32x4*)(rowp + bj * 128) = w; } }
        return false;
    }
};

template <bool MIX, bool RESBF> struct EpiRes {
    static constexpr bool PERM = true;
    const float* resf; bf16* xb; float* ssq;
    const LAS float* stab;
    __device__ __forceinline__ bool operator()(f32x4 (&acc)[2][2][4][2], const pg8::Unit& u, int wr, int wc, int fr, int fq) const {
        const int rt0 = wr * 64 + fr, row0 = u.pm * 256 + rt0, col0 = u.pn * 256 + wc * 32 + 8 * fq;
        const LAS float* st = stab + ((u.idx >> 1) & 3) * 512;
        if (MIX && u.aux == 0) {
#pragma unroll
            for (int ai = 0; ai < 2; ++ai)
#pragma unroll
                for (int m = 0; m < 4; ++m) { const float q = st[(rt0 + ai * 128 + m * 16) * 2];
#pragma unroll
                    for (int bj = 0; bj < 2; ++bj)
#pragma unroll
                        for (int n = 0; n < 2; ++n) acc[ai][bj][m][n] = acc[ai][bj][m][n] * q; }
            return true;
        }
#pragma unroll
        for (int ai = 0; ai < 2; ++ai)
#pragma unroll
            for (int m = 0; m < 4; ++m) { const int row = row0 + ai * 128 + m * 16; float s = 1.0f;
                if (MIX) s = st[(rt0 + ai * 128 + m * 16) * 2 + 1];
                const size_t off = (size_t)row * DM + col0; float q = 0.f;
#pragma unroll
                for (int bj = 0; bj < 2; ++bj) { f32x4 r0, r1;
                    if (RESBF) { const u32x4 rw = *(const u32x4*)(xb + off + bj * 128); r0 = (f32x4){bflo(rw.x), bfhi(rw.x), bflo(rw.y), bfhi(rw.y)}; r1 = (f32x4){bflo(rw.z), bfhi(rw.z), bflo(rw.w), bfhi(rw.w)}; }
                    else { r0 = *(const f32x4*)(resf + off + bj * 128); r1 = *(const f32x4*)(resf + off + bj * 128 + 4); }
                    const f32x4 v0 = r0 + acc[ai][bj][m][0] * s, v1 = r1 + acc[ai][bj][m][1] * s; u32x4 w;
                    w.x = pg8::cvt_pk_bf16(v0[0], v0[1]); w.y = pg8::cvt_pk_bf16(v0[2], v0[3]); w.z = pg8::cvt_pk_bf16(v1[0], v1[1]); w.w = pg8::cvt_pk_bf16(v1[2], v1[3]);
                    *(u32x4*)(xb + off + bj * 128) = w;
                    q += ((v0[0] * v0[0] + v0[1] * v0[1]) + (v0[2] * v0[2] + v0[3] * v0[3])) + ((v1[0] * v1[0] + v1[1] * v1[1]) + (v1[2] * v1[2] + v1[3] * v1[3])); }
                q += __shfl_xor(q, 16); q += __shfl_xor(q, 32);
                if (fq == 0) ssq[(size_t)row * 16 + u.pn * 4 + wc] = q; }
        return false;
    }
};
__device__ __forceinline__ void p3_scale_table(Frame& F, const pg8::StaticOrder& S, LAS float* stab) {
    const float* ssqr = (const float*)(F.ws + WS_SSQR); const float* ssqa = (const float*)(F.ws + WS_SSQA);
    pg8::Unit u;
    for (int i = 0; i < 4 && S.next(i, u); ++i) {
        if (F.tid < 256) { const int row = u.pm * 256 + F.tid; float sr = 0.f, sa = 0.f;
#pragma unroll 8
            for (int j = 0; j < 32; ++j) sr += ssqr[(size_t)j * T + row];
#pragma unroll
            for (int j = 0; j < 8; ++j) sa += ssqa[(size_t)j * T + row];
            const float rr = 1.0f / sqrtf(sr * (1.0f / DRNN) + EPS), ra = 1.0f / sqrtf(sa * (1.0f / DATT) + EPS);
            stab[(i * 256 + F.tid) * 2] = rr / ra; stab[(i * 256 + F.tid) * 2 + 1] = ra; }
    }
    __syncthreads();
}

struct MoeTab { int mt_pref[NE + 1]; };
struct MoeOrder {
    const LAS int* pref;
    int G, c, ntile;
    __device__ __forceinline__ bool next(int i, pg8::Unit& u) const {
        const int L = i * G + c; if (L >= ntile * 4) return false;
        const int tl = L >> 2; u.pn = L & 3;
        int e = 0;
#pragma unroll
        for (int j = 1; j < NE; ++j) e += (pref[j] <= tl) ? 1 : 0;
        u.aux = e; u.pm = tl; u.idx = i; return true;
    }
};
struct GatherG {
    const bf16* A; const bf16* Bt; int lda, ldb, nt;
    static constexpr bool GATHER = true;
    __device__ __forceinline__ const char* a_base(const pg8::Unit&) const { return (const char*)A; }
    __device__ __forceinline__ const char* b_base(const pg8::Unit& u) const { return (const char*)(Bt + ((size_t)u.aux * 1024 + (size_t)u.pn * 256) * ldb); }
    __device__ __forceinline__ void a_voff(const pg8::Unit& u, const int (&R)[2], const int (&C)[2], unsigned (&v)[2][2], const LAS int* ltok) const {
#pragma unroll
        for (int h = 0; h < 2; ++h)
#pragma unroll
            for (int i = 0; i < 2; ++i) { const int tok = ltok[(u.idx & 7) * 256 + h * 128 + R[i]] >> 1; v[h][i] = (unsigned)(tok * lda + C[i]) * 2u; }
    }
};
struct DownG {
    const bf16* A; const bf16* Bt; int lda, ldb, nt;
    static constexpr bool GATHER = false;
    __device__ __forceinline__ const char* a_base(const pg8::Unit& u) const { return (const char*)(A + (size_t)u.pm * 256 * lda); }
    __device__ __forceinline__ const char* b_base(const pg8::Unit& u) const { return (const char*)(Bt + ((size_t)u.aux * 1024 + (size_t)u.pn * 256) * ldb); }
    __device__ __forceinline__ void a_voff(const pg8::Unit&, const int (&R)[2], const int (&C)[2], unsigned (&v)[2][2], const LAS int*) const {
#pragma unroll
        for (int h = 0; h < 2; ++h)
#pragma unroll
            for (int i = 0; i < 2; ++i) v[h][i] = (unsigned)((h * 128 + R[i]) * lda + C[i]) * 2u;
    }
};
struct EpiGateUp {
    static constexpr bool PERM = true;
    bf16* H; const LAS int* ltok; RsPart16 rs;
    __device__ __forceinline__ bool operator()(f32x4 (&acc)[2][2][4][2], const pg8::Unit& u, int wr, int wc, int fr, int fq) const {
        const int rt0 = wr * 64 + fr, row0 = u.pm * 256 + rt0, col0 = u.pn * 128 + wc * 32 + 8 * fq;
#pragma unroll
        for (int ai = 0; ai < 2; ++ai)
#pragma unroll
            for (int m = 0; m < 4; ++m) { bf16* rowp = H + (size_t)(row0 + ai * 128 + m * 16) * DE + col0; float h[8];
                int sl = ltok[(u.idx & 7) * 256 + rt0 + ai * 128 + m * 16]; sl = sl < 0 ? 0 : sl; const float rstd = rs(sl >> 1);
#pragma unroll
                for (int n = 0; n < 2; ++n)
#pragma unroll
                    for (int j = 0; j < 4; ++j) { const float gv = acc[ai][0][m][n][j] * rstd, uv = acc[ai][1][m][n][j] * rstd; h[n * 4 + j] = gv / (1.0f + __expf(-gv)) * uv; }
                u32x4 w; w.x = pg8::cvt_pk_bf16(h[0], h[1]); w.y = pg8::cvt_pk_bf16(h[2], h[3]); w.z = pg8::cvt_pk_bf16(h[4], h[5]); w.w = pg8::cvt_pk_bf16(h[6], h[7]);
                *(u32x4*)rowp = w; }
        return false;
    }
};
struct EpiDown {
    static constexpr bool PERM = true;
    bf16* Y; const float* slotw; const LAS int* ltok;
    __device__ __forceinline__ bool operator()(f32x4 (&acc)[2][2][4][2], const pg8::Unit& u, int wr, int wc, int fr, int fq) const {
        const int col0 = u.pn * 256 + wc * 32 + 8 * fq;
#pragma unroll
        for (int ai = 0; ai < 2; ++ai)
#pragma unroll
            for (int m = 0; m < 4; ++m) { const int slot = ltok[(u.idx & 7) * 256 + ai * 128 + wr * 64 + m * 16 + fr];
                if (slot >= 0) { const float s = slotw[slot]; bf16* rowp = Y + (size_t)slot * DM + col0;
#pragma unroll
                    for (int bj = 0; bj < 2; ++bj) { const f32x4 v0 = acc[ai][bj][m][0] * s, v1 = acc[ai][bj][m][1] * s; u32x4 w;
                        w.x = pg8::cvt_pk_bf16(v0[0], v0[1]); w.y = pg8::cvt_pk_bf16(v0[2], v0[3]); w.z = pg8::cvt_pk_bf16(v1[0], v1[1]); w.w = pg8::cvt_pk_bf16(v1[2], v1[3]);
                        *(u32x4*)(rowp + bj * 128) = w; } } }
        return false;
    }
};

__device__ __forceinline__ float sigmoidf_(float x) { return 1.0f / (1.0f + __expf(-x)); }
__device__ __forceinline__ float gelu_tanh(float x) { const float u = 0.7978845608028654f * (x + 0.044715f * x * x * x); return 0.5f * x * (1.0f + tanhf(u)); }

constexpr int RT = 256;
constexpr int RB_XR = 0;
constexpr int RB_XG = 37376;
constexpr int RB_SIZE = 45568;
constexpr int R_AGG = 2 * RB_SIZE;
constexpr int R_BW = R_AGG + 2048;
__device__ __forceinline__ float fast_sigmoid(float x) { return __builtin_amdgcn_rcpf(1.0f + __expf(-x)); }
__device__ __forceinline__ void rnn_item(Frame& F, int item) {
    const int b = item >> 5, cb = (item >> 2) & 7, sl = item & 3;
    const int tid = F.tid, lane = F.lane, wave = F.wave;
    LAS unsigned char* lds = F.lds;
    const bf16* proj = (const bf16*)(F.ws + WS_PROJ);
    bf16* ymix = (bf16*)(F.ws + WS_YMIX); float* ssqr = (float*)(F.ws + WS_SSQR);
    const int d = lane & 15, q4 = lane >> 4;
    const int chd = cb * 64 + sl * 16 + d;
    float cbr = F.in[7][chd], cbi = F.in[9][chd];
    __syncthreads();
    {
        const float* wa = F.in[6] + (size_t)cb * 64 * 64 + sl * 16 + d; const float* wx = F.in[8] + (size_t)cb * 64 * 64 + sl * 16 + d;
        const int gsel = wave >> 2, jj = wave & 3; const float* wsel = gsel ? wx : wa;
#pragma unroll
        for (int ks = 0; ks < 2; ++ks) { bf16x8 fr;
#pragma unroll
            for (int j = 0; j < 8; ++j) { const int c = 32 * ks + 8 * q4 + j; fr[j] = (short)f2bf(F.in[4][jj * DRNN + cb * 64 + c] * wsel[c * 64]); }
            *(LAS bf16x8*)(lds + R_BW + (((gsel * 4 + jj) * 2 + ks) * 64 + lane) * 16) = fr; }
        for (int c = 0; c < 64; ++c) { const float cbv = F.in[5][cb * 64 + c]; cbr += cbv * wa[c * 64]; cbi += cbv * wx[c * 64]; }
    }
    float cwd[4]; const float cbd = F.in[5][chd];
#pragma unroll
    for (int jj = 0; jj < 4; ++jj) cwd[jj] = F.in[4][jj * DRNN + chd];
    const float spc = -8.0f * log1pf(__expf(-F.in[10][chd]));
    float tcarry = 0.f;
    const bf16* xrbase = proj + (size_t)b * SEQ * DIN + cb * 64;
    const bf16* xgbase = proj + (size_t)b * SEQ * DIN + DRNN + cb * 64 + sl * 16;
    u32x4 pf[5], pg;
    auto issue = [&](int t0) {
#pragma unroll
        for (int k = 0; k < 5; ++k) { const int p = tid + 512 * k; const int row = p >> 3, c8 = p & 7; const int tk = t0 - 3 + row;
            pf[k] = (u32x4){0u, 0u, 0u, 0u};
            if ((k < 4 || tid < 24) && tk >= 0) pf[k] = *(const u32x4*)(xrbase + (size_t)tk * DIN + c8 * 8); }
        pg = *(const u32x4*)(xgbase + (size_t)(t0 + (tid >> 1)) * DIN + (tid & 1) * 8);
    };
    auto commit = [&](LAS unsigned char* buf) {
#pragma unroll
        for (int k = 0; k < 5; ++k) { const int p = tid + 512 * k; const int row = p >> 3, c8 = p & 7;
            if (k < 4 || tid < 24) *(LAS u32x4*)(buf + RB_XR + row * 144 + c8 * 16) = pf[k]; }
        *(LAS u32x4*)(buf + RB_XG + (tid >> 1) * 32 + (tid & 1) * 16) = pg;
    };
    issue(0); commit(lds);
    __syncthreads();
    for (int tile = 0; tile < SEQ / RT; ++tile) {
        const int t0 = tile * RT, cur = tile & 1;
        LAS unsigned char* buf = lds + cur * RB_SIZE;
        if (tile + 1 < SEQ / RT) issue(t0 + RT);
        float Pt[2][4], hl[2][4], gx[2][4];
        float Ac = 1.f, Hc = 0.f;
#pragma unroll
        for (int rt = 0; rt < 2; ++rt) {
            const int tb = 32 * wave + 16 * rt;
            f32x4 cr = {0.f, 0.f, 0.f, 0.f}, ci = {0.f, 0.f, 0.f, 0.f};
#pragma unroll
            for (int jj = 0; jj < 4; ++jj)
#pragma unroll
                for (int ks = 0; ks < 2; ++ks) { const bf16x8 a = *(const LAS bf16x8*)(buf + RB_XR + (tb + d + jj) * 144 + (32 * ks + 8 * q4) * 2);
                    const bf16x8 fa = *(const LAS bf16x8*)(lds + R_BW + ((jj * 2 + ks) * 64 + lane) * 16), fx = *(const LAS bf16x8*)(lds + R_BW + (((4 + jj) * 2 + ks) * 64 + lane) * 16);
                    cr = __builtin_amdgcn_mfma_f32_16x16x32_bf16(a, fa, cr, 0, 0, 0); ci = __builtin_amdgcn_mfma_f32_16x16x32_bf16(a, fx, ci, 0, 0, 0); }
            float xr7[7];
#pragma unroll
            for (int r = 0; r < 7; ++r) xr7[r] = bf2f(*(const LAS unsigned short*)(buf + RB_XR + (tb + 4 * q4 + r) * 144 + (sl * 16 + d) * 2));
            float av[4], uv[4];
#pragma unroll
            for (int j = 0; j < 4; ++j) { const float xc = cbd + cwd[0] * xr7[j] + cwd[1] * xr7[j + 1] + cwd[2] * xr7[j + 2] + cwd[3] * xr7[j + 3];
                const float r = fast_sigmoid(cr[j] + cbr), ig = fast_sigmoid(ci[j] + cbi); const float a = __expf(spc * r);
                av[j] = a; uv[j] = __builtin_amdgcn_sqrtf(fmaxf(1.0f - a * a, 0.f)) * (ig * xc);
                const float xg = bf2f(*(const LAS unsigned short*)(buf + RB_XG + (tb + 4 * q4 + j) * 32 + d * 2));
                const float uu = 0.7978845608028654f * (xg + 0.044715f * xg * xg * xg); gx[rt][j] = xg * __builtin_amdgcn_rcpf(1.0f + __expf(-2.0f * uu)); }
            float p[4], h[4];
            p[0] = av[0]; h[0] = uv[0];
#pragma unroll
            for (int j = 1; j < 4; ++j) { p[j] = av[j] * p[j - 1]; h[j] = av[j] * h[j - 1] + uv[j]; }
            float A = p[3], H = h[3];
            { const float A1 = __shfl_up(A, 16), H1 = __shfl_up(H, 16); if (q4 >= 1) { H = A * H1 + H; A = A * A1; } }
            { const float A2 = __shfl_up(A, 32), H2 = __shfl_up(H, 32); if (q4 >= 2) { H = A * H2 + H; A = A * A2; } }
            float Ae = __shfl_up(A, 16), He = __shfl_up(H, 16); if (q4 == 0) { Ae = 1.f; He = 0.f; }
            const float Art = __shfl(A, 48 + d), Hrt = __shfl(H, 48 + d);
            const float hin = Ae * Hc + He, Pin = Ac * Ae;
#pragma unroll
            for (int j = 0; j < 4; ++j) { hl[rt][j] = p[j] * hin + h[j]; Pt[rt][j] = Pin * p[j]; }
            Hc = Art * Hc + Hrt; Ac = Ac * Art;
        }
        LAS float* agg = (LAS float*)(lds + R_AGG) + cur * 256;
        if (q4 == 0) { agg[wave * 32 + d] = Ac; agg[wave * 32 + 16 + d] = Hc; }
        if (tile + 1 < SEQ / RT) commit(lds + (cur ^ 1) * RB_SIZE);
        __syncthreads();
        float hin = tcarry, myh = 0.f;
#pragma unroll
        for (int w = 0; w < 8; ++w) { if (w == wave) myh = hin; hin = agg[w * 32 + d] * hin + agg[w * 32 + 16 + d]; }
        tcarry = hin;
#pragma unroll
        for (int rt = 0; rt < 2; ++rt) {
            const int tb = 32 * wave + 16 * rt; const size_t row0 = (size_t)b * SEQ + t0 + tb + 4 * q4;
            float s2[4];
#pragma unroll
            for (int j = 0; j < 4; ++j) { const float hv = hl[rt][j] + Pt[rt][j] * myh; const float y = gx[rt][j] * hv;
                ymix[(row0 + j) * DM + chd] = (bf16)f2bf(y); s2[j] = y * y; }
#pragma unroll
            for (int j = 0; j < 4; ++j) { s2[j] += __shfl_xor(s2[j], 1); s2[j] += __shfl_xor(s2[j], 2); s2[j] += __shfl_xor(s2[j], 4); s2[j] += __shfl_xor(s2[j], 8); }
            if (d == 0) *(f32x4*)(ssqr + (size_t)(cb * 4 + sl) * T + row0) = (f32x4){s2[0], s2[1], s2[2], s2[3]};
        }
    }
    __syncthreads();
}

constexpr int A_BUF = 18432;
constexpr int A_BIAS = 2 * A_BUF;
__device__ __forceinline__ void attn_item(Frame& F, int item) {
    const int h = item & 7, b = (item >> 3) & 7, cg = item >> 6, c0 = cg * 4;
    const int tid = F.tid, lane = F.lane, wave = F.wave, r32 = lane & 31, hi = lane >> 5;
    const int ci = wave >> 1, qb = wave & 1;
    const bf16* proj = (const bf16*)(F.ws + WS_PROJ);
    bf16* ymix = (bf16*)(F.ws + WS_YMIX); float* ssqa = (float*)(F.ws + WS_SSQA);
    LAS unsigned char* lds = F.lds;
    LAS float* bl = (LAS float*)(lds + A_BIAS);
    if (tid < 257) bl[tid] = F.in[11][h * 257 + tid];
    const float bfar = F.in[11][h * 257 + 256];
    const size_t qrow = (size_t)b * SEQ + (c0 + ci) * CHUNK + qb * 32 + r32;
    bf16x8 qf[4];
#pragma unroll
    for (int ks = 0; ks < 4; ++ks) qf[ks] = *(const bf16x8*)(proj + qrow * DIN + 1024 + h * HD + ks * 16 + hi * 8);
    f32x16 o[2];
#pragma unroll
    for (int i = 0; i < 2; ++i)
#pragma unroll
        for (int r = 0; r < 16; ++r) o[i][r] = 0.f;
    float mrun = -1e30f, lrun = 0.f;
    const int srow = tid >> 3, sc8 = tid & 7;
    const bf16* kvbase = proj + ((size_t)b * SEQ + srow) * DIN + 1536 + h * HD + sc8 * 8;
    const int j0 = c0 >= 8 ? 0 : 8 - c0;
    u32x4 pk, pv;
    { const bf16* p = kvbase + (size_t)(c0 - 8 + j0) * CHUNK * DIN; pk = *(const u32x4*)p; pv = *(const u32x4*)(p + 512); }
    *(LAS u32x4*)(lds + (j0 & 1) * A_BUF + srow * 144 + sc8 * 16) = pk; *(LAS u32x4*)(lds + (j0 & 1) * A_BUF + 9216 + srow * 144 + sc8 * 16) = pv;
    __syncthreads();
    for (int j = j0; j < 12; ++j) {
        const LAS unsigned char* kt = lds + (j & 1) * A_BUF; const LAS unsigned char* vt = kt + 9216;
        if (j + 1 < 12) { const bf16* p = kvbase + (size_t)(c0 - 8 + j + 1) * CHUNK * DIN; pk = *(const u32x4*)p; pv = *(const u32x4*)(p + 512); }
        if (j >= ci && j <= ci + 8) {
            f32x16 s[2];
#pragma unroll
            for (int kb = 0; kb < 2; ++kb) { f32x16 z;
#pragma unroll
                for (int r = 0; r < 16; ++r) z[r] = 0.f;
#pragma unroll
                for (int ks = 0; ks < 4; ++ks) { const bf16x8 kf = *(const LAS bf16x8*)(kt + (32 * kb + r32) * 144 + (16 * ks + 8 * hi) * 2); z = __builtin_amdgcn_mfma_f32_32x32x16_bf16(kf, qf[ks], z, 0, 0, 0); }
                s[kb] = z; }
            const int dc = ci + 8 - j;
            if (dc >= 3) {
#pragma unroll
                for (int kb = 0; kb < 2; ++kb)
#pragma unroll
                    for (int r = 0; r < 16; ++r) s[kb][r] += bfar;
            } else {
#pragma unroll
                for (int kb = 0; kb < 2; ++kb)
#pragma unroll
                    for (int r = 0; r < 16; ++r) { const int kk = kb * 32 + (r & 3) + 8 * (r >> 2) + 4 * hi; int dist = dc * 64 + qb * 32 + r32 - kk; dist = dist > 128 ? 128 : dist;
                        s[kb][r] += bl[dist + 128]; }
            }
            float mx = s[0][0];
#pragma unroll
            for (int r = 0; r < 16; ++r) { mx = fmaxf(mx, s[0][r]); mx = fmaxf(mx, s[1][r]); }
            mx = fmaxf(mx, __shfl_xor(mx, 32));
            const float mn = fmaxf(mrun, mx); const float alpha = __expf(mrun - mn); mrun = mn;
            float sum = 0.f;
#pragma unroll
            for (int kb = 0; kb < 2; ++kb)
#pragma unroll
                for (int r = 0; r < 16; ++r) { const float p = __expf(s[kb][r] - mn); s[kb][r] = p; sum += p; }
            lrun = lrun * alpha + sum;
#pragma unroll
            for (int db = 0; db < 2; ++db)
#pragma unroll
                for (int r = 0; r < 16; ++r) o[db][r] *= alpha;
#pragma unroll
            for (int kb = 0; kb < 2; ++kb)
#pragma unroll
                for (int s2 = 0; s2 < 2; ++s2) { u32x4 w;
                    w.x = pg8::cvt_pk_bf16(s[kb][8 * s2 + 0], s[kb][8 * s2 + 1]); w.y = pg8::cvt_pk_bf16(s[kb][8 * s2 + 2], s[kb][8 * s2 + 3]);
                    w.z = pg8::cvt_pk_bf16(s[kb][8 * s2 + 4], s[kb][8 * s2 + 5]); w.w = pg8::cvt_pk_bf16(s[kb][8 * s2 + 6], s[kb][8 * s2 + 7]);
                    const bf16x8 pf = __builtin_bit_cast(bf16x8, w);
#pragma unroll
                    for (int db = 0; db < 2; ++db) {
                        const int key0 = 32 * kb + 16 * s2 + 4 * hi, li = lane & 15, dg = (lane >> 4) & 1;
                        const LAS unsigned char* p0 = vt + (key0 + (li >> 2)) * 144 + (32 * db + 16 * dg + 4 * (li & 3)) * 2;
                        const s16x4 v0 = __builtin_bit_cast(s16x4, __builtin_amdgcn_ds_read_tr16_b64_v4i16((LAS s16x4*)p0));
                        const s16x4 v1 = __builtin_bit_cast(s16x4, __builtin_amdgcn_ds_read_tr16_b64_v4i16((LAS s16x4*)(p0 + 8 * 144)));
                        const bf16x8 vf = (bf16x8){v0[0], v0[1], v0[2], v0[3], v1[0], v1[1], v1[2], v1[3]};
                        o[db] = __builtin_amdgcn_mfma_f32_32x32x16_bf16(vf, pf, o[db], 0, 0, 0);
                    }
                }
        }
        if (j + 1 < 12) { LAS unsigned char* nb = lds + ((j + 1) & 1) * A_BUF; *(LAS u32x4*)(nb + srow * 144 + sc8 * 16) = pk; *(LAS u32x4*)(nb + 9216 + srow * 144 + sc8 * 16) = pv; }
        __syncthreads();
    }
    {
        const float l = lrun + __shfl_xor(lrun, 32); const float il = 1.0f / l; float s2 = 0.f;
#pragma unroll
        for (int db = 0; db < 2; ++db)
#pragma unroll
            for (int g4 = 0; g4 < 4; ++g4) { const float v0 = o[db][4 * g4 + 0] * il, v1 = o[db][4 * g4 + 1] * il, v2 = o[db][4 * g4 + 2] * il, v3 = o[db][4 * g4 + 3] * il;
                s2 += (v0 * v0 + v1 * v1) + (v2 * v2 + v3 * v3);
                u32x2 w; w.x = pg8::cvt_pk_bf16(v0, v1); w.y = pg8::cvt_pk_bf16(v2, v3);
                *(u32x2*)(ymix + qrow * DM + DRNN + h * HD + db * 32 + 8 * g4 + 4 * hi) = w; }
        s2 += __shfl_xor(s2, 32);
        if (hi == 0) ssqa[(size_t)h * T + qrow] = s2;
    }
}
constexpr int X_VT = 0;
__device__ __forceinline__ void xattn_item(Frame& F, int item) {
    const int b = item & 7, hd = (item >> 3) & 3, qt = item >> 5;
    const int lane = F.lane, wave = F.wave, tid = F.tid, r32 = lane & 31, hi = lane >> 5;
    const bf16* qx = (const bf16*)(F.ws + WS_QX); const bf16* kv = (const bf16*)(F.ws + WS_KV); bf16* O = (bf16*)(F.ws + WS_O);
    LAS unsigned char* vt = F.lds + X_VT;
    const size_t qrow = (size_t)b * SEQ + qt * 256 + wave * 32 + r32;
    const bf16* qp = qx + qrow * DM + hd * XD + hi * 8;
    const bf16* kp = kv + ((size_t)b * NMEM + r32) * 2048 + hd * XD + hi * 8;
    f32x16 s[8];
#pragma unroll
    for (int kb = 0; kb < 8; ++kb)
#pragma unroll
        for (int r = 0; r < 16; ++r) s[kb][r] = 0.f;
#pragma unroll 2
    for (int ks = 0; ks < 16; ++ks) {
        const bf16x8 qf = *(const bf16x8*)(qp + ks * 16);
#pragma unroll
        for (int kb = 0; kb < 8; ++kb) { const bf16x8 kf = *(const bf16x8*)(kp + (size_t)kb * 32 * 2048 + ks * 16);
            s[kb] = __builtin_amdgcn_mfma_f32_32x32x16_bf16(kf, qf, s[kb], 0, 0, 0); }
    }
    float mx = s[0][0];
#pragma unroll
    for (int kb = 0; kb < 8; ++kb)
#pragma unroll
        for (int r = 0; r < 16; ++r) mx = fmaxf(mx, s[kb][r]);
    mx = fmaxf(mx, __shfl_xor(mx, 32));
    float sum = 0.f;
    bf16x8 pf[8][2];
#pragma unroll
    for (int kb = 0; kb < 8; ++kb) {
#pragma unroll
        for (int r = 0; r < 16; ++r) { const float p = __expf(s[kb][r] - mx); s[kb][r] = p; sum += p; }
#pragma unroll
        for (int s2 = 0; s2 < 2; ++s2) { u32x4 w;
            w.x = pg8::cvt_pk_bf16(s[kb][8 * s2 + 0], s[kb][8 * s2 + 1]); w.y = pg8::cvt_pk_bf16(s[kb][8 * s2 + 2], s[kb][8 * s2 + 3]);
            w.z = pg8::cvt_pk_bf16(s[kb][8 * s2 + 4], s[kb][8 * s2 + 5]); w.w = pg8::cvt_pk_bf16(s[kb][8 * s2 + 6], s[kb][8 * s2 + 7]);
            pf[kb][s2] = __builtin_bit_cast(bf16x8, w); }
    }
    sum += __shfl_xor(sum, 32);
    const float il = 1.0f / sum;
    f32x16 o[8];
#pragma unroll
    for (int db = 0; db < 8; ++db)
#pragma unroll
        for (int r = 0; r < 16; ++r) o[db][r] = 0.f;
#pragma unroll
    for (int kt = 0; kt < 4; ++kt) {
        __syncthreads();
#pragma unroll
        for (int p = 0; p < 4; ++p) { const int key = p * 16 + (tid >> 5), ch = tid & 31;
            const u32x4 v = *(const u32x4*)(kv + ((size_t)b * NMEM + kt * 64 + key) * 2048 + 1024 + hd * XD + ch * 8);
            *(LAS u32x4*)(vt + key * 528 + ch * 16) = v; }
        __syncthreads();
#pragma unroll
        for (int kb2 = 0; kb2 < 2; ++kb2)
#pragma unroll
            for (int s2 = 0; s2 < 2; ++s2) {
                const int key0 = 32 * kb2 + 16 * s2 + 4 * hi, li = lane & 15, dg = (lane >> 4) & 1;
                const LAS unsigned char* pb = vt + (key0 + (li >> 2)) * 528 + (16 * dg + 4 * (li & 3)) * 2;
#pragma unroll
                for (int db = 0; db < 8; ++db) {
                    const s16x4 v0 = __builtin_bit_cast(s16x4, __builtin_amdgcn_ds_read_tr16_b64_v4i16((LAS s16x4*)(pb + db * 64)));
                    const s16x4 v1 = __builtin_bit_cast(s16x4, __builtin_amdgcn_ds_read_tr16_b64_v4i16((LAS s16x4*)(pb + db * 64 + 8 * 528)));
                    const bf16x8 vf = (bf16x8){v0[0], v0[1], v0[2], v0[3], v1[0], v1[1], v1[2], v1[3]};
                    o[db] = __builtin_amdgcn_mfma_f32_32x32x16_bf16(vf, pf[kt * 2 + kb2][s2], o[db], 0, 0, 0);
                }
            }
    }
    bf16* op = O + qrow * DM + hd * XD + 4 * hi;
#pragma unroll
    for (int db = 0; db < 8; ++db)
#pragma unroll
        for (int g4 = 0; g4 < 4; ++g4) { u32x2 w; w.x = pg8::cvt_pk_bf16(o[db][4 * g4 + 0] * il, o[db][4 * g4 + 1] * il); w.y = pg8::cvt_pk_bf16(o[db][4 * g4 + 2] * il, o[db][4 * g4 + 3] * il);
            *(u32x2*)(op + db * 32 + 8 * g4) = w; }
}

constexpr int RL_W = 0;
constexpr int RL_LOG = 99328;
constexpr int RL_CNT = RL_LOG + 20480;
__device__ __forceinline__ void p7_router(Frame& F) {
    const int lane = F.lane, wave = F.wave, tid = F.tid, fr = lane & 15, fq = lane >> 4;
    const bf16* xb = (const bf16*)(F.ws + WS_XB); const bf16* WrT = (const bf16*)(F.ws + WS_WR);
    const float* ssq2 = (const float*)(F.ws + WS_SSQ2);
    float* slotw = (float*)(F.ws + WS_SLOTW); int* list = (int*)(F.ws + WS_LIST);
    unsigned* gcnt = (unsigned*)(F.ws + WS_CTL) + CW_CNT;
    LAS float* lg = (LAS float*)(F.lds + RL_LOG) + wave * 16 * 40;
    LAS int* lcnt = (LAS int*)(F.lds + RL_CNT); LAS int* lbase = lcnt + 32;
#pragma unroll
    for (int k = 0; k < 12; ++k) { const int p = tid + 512 * k, row = p >> 7, c = p & 127;
        *(LAS u32x4*)(F.lds + RL_W + row * 2064 + c * 16) = *(const u32x4*)(WrT + (size_t)row * DM + c * 8); }
    for (int blk = blockIdx.x; blk < T / 128; blk += F.G) {
        const int tok0 = blk * 128 + wave * 16;
        if (tid < 32) lcnt[tid] = 0;
        __syncthreads();
        f32x4 c0 = {0.f, 0.f, 0.f, 0.f}, c1 = c0, c2 = c0;
        const bf16* ap = xb + (size_t)(tok0 + fr) * DM + fq * 8;
        const LAS unsigned char* bp = F.lds + RL_W + fr * 2064 + fq * 16;
#pragma unroll 8
        for (int ks = 0; ks < 32; ++ks) { const bf16x8 a = *(const bf16x8*)(ap + ks * 32);
            const bf16x8 b0 = *(const LAS bf16x8*)(bp + ks * 64), b1 = *(const LAS bf16x8*)(bp + 16 * 2064 + ks * 64), b2 = *(const LAS bf16x8*)(bp + 32 * 2064 + ks * 64);
            c0 = __builtin_amdgcn_mfma_f32_16x16x32_bf16(a, b0, c0, 0, 0, 0); c1 = __builtin_amdgcn_mfma_f32_16x16x32_bf16(a, b1, c1, 0, 0, 0); c2 = __builtin_amdgcn_mfma_f32_16x16x32_bf16(a, b2, c2, 0, 0, 0); }
#pragma unroll
        for (int j = 0; j < 4; ++j) { lg[(4 * fq + j) * 40 + fr] = c0[j]; lg[(4 * fq + j) * 40 + 16 + fr] = c1[j]; if (fr < 8) lg[(4 * fq + j) * 40 + 32 + fr] = c2[j]; }
        LDS_WAIT();
        int e0 = 0, e1 = 0; float w0 = 0.f, w1 = 0.f; int lp0 = 0, lp1 = 0;
        if (lane < 16) {
            const int tok = tok0 + lane; const RsPart16 rsp{ssq2}; const float rstd = rsp(tok);
            float gl[4]; int gi = 0;
#pragma unroll
            for (int j = 0; j < 4; ++j) gl[j] = lg[lane * 40 + j] * rstd + F.in[23][j];
            float gm = gl[0];
#pragma unroll
            for (int j = 1; j < 4; ++j) if (gl[j] > gm) { gm = gl[j]; gi = j; }
            float gs = 0.f;
#pragma unroll
            for (int j = 0; j < 4; ++j) gs += __expf(gl[j] - gm);
            const float gp = 1.0f / gs;
            float el[8];
#pragma unroll
            for (int j = 0; j < 8; ++j) el[j] = lg[lane * 40 + 4 + gi * 8 + j] * rstd + F.in[25][gi * 8 + j];
            int i0 = 0; float m0 = el[0];
#pragma unroll
            for (int j = 1; j < 8; ++j) if (el[j] > m0) { m0 = el[j]; i0 = j; }
            int i1 = -1; float m1 = -3.0e38f;
#pragma unroll
            for (int j = 0; j < 8; ++j) if (j != i0 && el[j] > m1) { m1 = el[j]; i1 = j; }
            const float p1 = __expf(m1 - m0); const float inv = 1.0f / (1.0f + p1);
            e0 = gi * 8 + i0; e1 = gi * 8 + i1; w0 = gp * inv; w1 = gp * p1 * inv;
            lp0 = atomicAdd((int*)&lcnt[e0], 1); lp1 = atomicAdd((int*)&lcnt[e1], 1);
            slotw[2 * tok] = w0; slotw[2 * tok + 1] = w1;
        }
        __syncthreads();
        if (tid < 32) lbase[tid] = (int)atomicAdd(&gcnt[tid], (unsigned)lcnt[tid]);
        __syncthreads();
        if (lane < 16) { const int tok = tok0 + lane;
            list[(size_t)e0 * T + lbase[e0] + lp0] = 2 * tok; list[(size_t)e1 * T + lbase[e1] + lp1] = 2 * tok + 1; }
        __syncthreads();
    }
}

__device__ __forceinline__ int moe_tables(Frame& F, LAS int* pref) {
    const unsigned* gcnt = (const unsigned*)(F.ws + WS_CTL) + CW_CNT;
    if (F.tid == 0) { int acc = 0; for (int e = 0; e < NE; ++e) { pref[e] = acc; acc += ((int)__hip_atomic_load(gcnt + e, RLX_AGENT) + 255) >> 8; } pref[NE] = acc; }
    __syncthreads();
    return pref[NE];
}
__device__ __forceinline__ void moe_fill_tok(Frame& F, const MoeOrder& S, LAS int* ltok, const LAS int* pref) {
    const unsigned* gcnt = (const unsigned*)(F.ws + WS_CTL) + CW_CNT; const int* list = (const int*)(F.ws + WS_LIST);
    pg8::Unit u;
    for (int i = 0; i < 8 && S.next(i, u); ++i) {
        if (F.tid < 256) { const int e = u.aux, r = (u.pm - pref[e]) * 256 + F.tid; const int cnt = (int)__hip_atomic_load(gcnt + e, RLX_AGENT);
            ltok[i * 256 + F.tid] = (r < cnt) ? list[(size_t)e * T + r] : -1; }
    }
    __syncthreads();
}
struct GatherG2 : GatherG {
    __device__ __forceinline__ void a_voff(const pg8::Unit& u, const int (&R)[2], const int (&C)[2], unsigned (&v)[2][2], const LAS int* ltok) const {
#pragma unroll
        for (int h = 0; h < 2; ++h)
#pragma unroll
            for (int i = 0; i < 2; ++i) { int sl = ltok[(u.idx & 7) * 256 + h * 128 + R[i]]; sl = sl < 0 ? 0 : sl; v[h][i] = (unsigned)((sl >> 1) * lda + C[i]) * 2u; }
    }
};

__device__ __forceinline__ void p10_final(Frame& F) {
    const int gw = F.vcu * NWAVES + F.wave, NGW = F.G * NWAVES, lane = F.lane;
    const bf16* Y = (const bf16*)(F.ws + WS_YSLOT); const bf16* XB = (const bf16*)(F.ws + WS_XB); float* out = F.out; const f32x4* fw = (const f32x4*)F.in[29] + lane;
    for (int m = gw; m < T; m += NGW) {
        f32x4* xo = (f32x4*)(out + (size_t)m * DM) + lane; const u32x2* xr = (const u32x2*)(XB + (size_t)m * DM) + lane;
        const u32x2* y0 = (const u32x2*)(Y + (size_t)(2 * m) * DM) + lane; const u32x2* y1 = (const u32x2*)(Y + (size_t)(2 * m + 1) * DM) + lane;
        f32x4 v[4]; float s = 0.f;
#pragma unroll
        for (int j = 0; j < 4; ++j) { const u32x2 x = xr[64 * j], a = y0[64 * j], c = y1[64 * j];
            v[j].x = bflo(x.x) + (bflo(a.x) + bflo(c.x)); v[j].y = bfhi(x.x) + (bfhi(a.x) + bfhi(c.x)); v[j].z = bflo(x.y) + (bflo(a.y) + bflo(c.y)); v[j].w = bfhi(x.y) + (bfhi(a.y) + bfhi(c.y));
            s += (v[j].x * v[j].x + v[j].y * v[j].y) + (v[j].z * v[j].z + v[j].w * v[j].w); }
        const float rstd = 1.0f / sqrtf(wave_sum(s) * (1.0f / DM) + EPS);
#pragma unroll
        for (int j = 0; j < 4; ++j) { const f32x4 w = fw[64 * j]; xo[64 * j] = v[j] * rstd * w; }
    }
}

constexpr int N_PHASES = 12;
__global__ void __launch_bounds__(NTHR, 2) hymba_fwd(Args args) {
    extern __shared__ __attribute__((aligned(16))) unsigned char lds_raw[];
    Frame F;
    F.lds = (LAS unsigned char*)lds_raw;
    F.tid = threadIdx.x; F.lane = F.tid & 63; F.wave = __builtin_amdgcn_readfirstlane(F.tid >> 6);
    F.G = gridDim.x; { const int bx = blockIdx.x; F.vcu = (F.G % 8 == 0) ? (bx % 8) * (F.G / 8) + bx / 8 : bx; }
    F.in = args.in; F.ws = args.ws; F.out = args.out;
    unsigned char* ws = args.ws;
    volatile LAS unsigned* MISC = (volatile LAS unsigned*)(F.lds + LDS_MISC);
    LAS int* ltok = (LAS int*)(F.lds + LDS_TOK);
    LAS int* pref = (LAS int*)(F.lds + LDS_MISC + 256);
    if (F.tid < 64) MISC[F.tid] = 0u;
    __syncthreads();
    XcdBarrier bar; bar.bar = (unsigned*)(ws + WS_CTL) + CW_BAR; bar.x = 0; bar.st = nullptr;
    if (MK_N_LAUNCHES == 1) bar = xcd_barrier_post((unsigned*)(ws + WS_CTL) + CW_BAR, MISC + 8);
    const int lo = args.ph_lo, hi = args.ph_hi;
#ifndef PH_MASK
#define PH_MASK 0xfff
#endif
#define IN(k) (((PH_MASK >> (k)) & 1) && lo <= (k) && (k) < hi)
#define SEAM(k) do { if (IN(k) && IN((k) + 1)) xcd_barrier(bar); } while (0)
#ifndef PH_TWICE
#define PH_TWICE 0
#endif
#define REP(k)

    if (IN(0)) REP(0) { p0_prologue(F); } SEAM(0);
    if (IN(1)) REP(1) {
        { pg8::DenseG g{(const bf16*)(ws + WS_XB), (const bf16*)(ws + WS_WIN), DM, DM, DM / 64, 0}; pg8::StaticOrder S; S.init(T, DIN, F.G, (int)blockIdx.x);
          EpiBf16<RsArr> E{(bf16*)(ws + WS_PROJ), DIN, RsArr{(const float*)(ws + WS_RSTD1)}};
          pg8::gemm_phase<pg8::DenseG, EpiBf16<RsArr>, pg8::StaticOrder, true>(F.lds, ltok, g, S, E); }
        { pg8::DenseG g{(const bf16*)(ws + WS_MEMN), (const bf16*)(ws + WS_WKV), DM, DM, DM / 64, 0}; pg8::StaticOrder S; S.init(MT, 2048, F.G, (int)blockIdx.x);
          EpiBf16<RsNone> E{(bf16*)(ws + WS_KV), 2048, RsNone{}};
          pg8::gemm_phase<pg8::DenseG, EpiBf16<RsNone>, pg8::StaticOrder, true>(F.lds, ltok, g, S, E); }
    } SEAM(1);
    if (IN(2)) REP(2) { for (int it = blockIdx.x; it < 256; it += F.G) rnn_item(F, it); } SEAM(2);
    if (IN(3)) REP(3) { for (int it = blockIdx.x; it < BATCH * NH * (NCHUNK / 4); it += F.G) attn_item(F, it); } SEAM(3);
    if (IN(4)) REP(4) {
        pg8::DenseG g{(const bf16*)(ws + WS_YMIX), (const bf16*)(ws + WS_WOUT), DM, DM, 8, 512}; pg8::TwoHalfOrder S; S.s.init(T, DM, F.G, (int)blockIdx.x);
        p3_scale_table(F, S.s, (LAS float*)(F.lds + LDS_TOK));
        EpiRes<true, false> E{F.in[0], (bf16*)(ws + WS_XB), (float*)(ws + WS_SSQ1), (const LAS float*)(F.lds + LDS_TOK)};
        pg8::gemm_phase<pg8::DenseG, EpiRes<true, false>, pg8::TwoHalfOrder, true>(F.lds, ltok, g, S, E);
    } SEAM(4);
    if (IN(5)) REP(5) {
        pg8::DenseG g{(const bf16*)(ws + WS_XB), (const bf16*)(ws + WS_WQ), DM, DM, DM / 64, 0}; pg8::StaticOrder S; S.init(T, DM, F.G, (int)blockIdx.x);
        EpiBf16<RsPart16> E{(bf16*)(ws + WS_QX), DM, RsPart16{(const float*)(ws + WS_SSQ1)}};
        pg8::gemm_phase<pg8::DenseG, EpiBf16<RsPart16>, pg8::StaticOrder, true>(F.lds, ltok, g, S, E);
    } SEAM(5);
    if (IN(6)) REP(6) { for (int it = blockIdx.x; it < BATCH * XH * (SEQ / 256); it += F.G) xattn_item(F, it); } SEAM(6);
    if (IN(7)) REP(7) {
        pg8::DenseG g{(const bf16*)(ws + WS_O), (const bf16*)(ws + WS_WO), DM, DM, DM / 64, 0}; pg8::StaticOrder S; S.init(T, DM, F.G, (int)blockIdx.x);
        EpiRes<false, true> E{nullptr, (bf16*)(ws + WS_XB), (float*)(ws + WS_SSQ2), (const LAS float*)(F.lds + LDS_TOK)};
        pg8::gemm_phase<pg8::DenseG, EpiRes<false, true>, pg8::StaticOrder, true>(F.lds, ltok, g, S, E);
    } SEAM(7);
    if (IN(8)) REP(8) { p7_router(F); } SEAM(8);
    if (IN(9)) REP(9) {
        const int ntile = moe_tables(F, pref);
        MoeOrder S{pref, F.G, (int)blockIdx.x, ntile};
        moe_fill_tok(F, S, ltok, pref);
        GatherG2 g; g.A = (const bf16*)(ws + WS_XB); g.Bt = (const bf16*)(ws + WS_WGU); g.lda = DM; g.ldb = DM; g.nt = DM / 64;
        EpiGateUp E{(bf16*)(ws + WS_HID), ltok, RsPart16{(const float*)(ws + WS_SSQ2)}};
        pg8::gemm_phase<GatherG2, EpiGateUp, MoeOrder, true>(F.lds, ltok, g, S, E);
    } SEAM(9);
    if (IN(10)) REP(10) {
        const int ntile = moe_tables(F, pref);
        MoeOrder S{pref, F.G, (int)blockIdx.x, ntile};
        moe_fill_tok(F, S, ltok, pref);
        DownG g{(const bf16*)(ws + WS_HID), (const bf16*)(ws + WS_WD), DE, DE, DE / 64};
        EpiDown E{(bf16*)(ws + WS_YSLOT), (const float*)(ws + WS_SLOTW), ltok};
        pg8::gemm_phase<DownG, EpiDown, MoeOrder, true>(F.lds, ltok, g, S, E);
    } SEAM(10);
    if (IN(11)) REP(11) { p10_final(F); }
#undef IN
#undef SEAM
}

extern "C" void kernel_launch(void* const* d_in, const int* in_sizes, int n_in, void* d_out, int out_size, void* d_ws, size_t ws_size, hipStream_t stream) {
    static int grid = 0;
    if (grid == 0) {
        if (n_in != 30 || in_sizes[0] != T * DM || out_size != T * DM || ws_size < WS_END) {
            fprintf(stderr, "kernel_launch: unexpected shapes: n_in %d in0 %d out %d ws %zu (need %zu)\n", n_in, n_in > 0 ? in_sizes[0] : -1, out_size, ws_size, (size_t)WS_END); grid = -1; return; }
        int dev = 0, cus = 0, per_cu = 0;
        if (hipGetDevice(&dev) != hipSuccess || hipDeviceGetAttribute(&cus, hipDeviceAttributeMultiprocessorCount, dev) != hipSuccess) { grid = -1; return; }
        if (hipFuncSetAttribute((const void*)hymba_fwd, hipFuncAttributeMaxDynamicSharedMemorySize, LDS_BYTES) != hipSuccess) { fprintf(stderr, "kernel_launch: hipFuncSetAttribute failed\n"); grid = -1; return; }
        if (hipOccupancyMaxActiveBlocksPerMultiprocessor(&per_cu, (const void*)hymba_fwd, NTHR, LDS_BYTES) != hipSuccess || per_cu < 1) { fprintf(stderr, "kernel_launch: occupancy query failed (%d)\n", per_cu); (void)hipGetLastError(); grid = -1; return; }
        grid = cus;
    }
    if (grid < 0) return;
    (void)hipMemsetAsync((char*)d_ws + WS_CTL, 0, CTL_ZERO_BYTES, stream);
    Args a{};
    for (int i = 0; i < 30; ++i) a.in[i] = (const float*)d_in[i];
    a.out = (float*)d_out; a.ws = (unsigned char*)d_ws;
    if (MK_N_LAUNCHES == 1) {
        a.ph_lo = 0; a.ph_hi = N_PHASES;
        void* kargs[] = {&a};
        hipError_t e = hipLaunchCooperativeKernel((const void*)hymba_fwd, dim3(grid), dim3(NTHR), kargs, LDS_BYTES, stream);
        if (e != hipSuccess) fprintf(stderr, "cooperative launch failed: %s (grid %d)\n", hipGetErrorString(e), grid);
    } else {
        for (int p = 0; p < N_PHASES; ++p) { a.ph_lo = p; a.ph_hi = p + 1;
            for (int rep = 0; rep < ((p == PH_DUP) ? 2 : 1); ++rep) hipLaunchKernelGGL(hymba_fwd, dim3(grid), dim3(NTHR), LDS_BYTES, stream, a); }
    }
}
```

```cpp
#include <hip/hip_runtime.h>
#include <cstdio>
#include <cstdint>

#ifndef PH_DUP
#define PH_DUP -1
#endif
#ifndef MK_N_LAUNCHES
#define MK_N_LAUNCHES 1
#endif

#define LAS __attribute__((address_space(3)))
#define GAS __attribute__((address_space(1)))
typedef unsigned short bf16;
typedef short bf16x8 __attribute__((ext_vector_type(8)));
typedef short s16x4 __attribute__((ext_vector_type(4)));
typedef float f32x4 __attribute__((ext_vector_type(4)));
typedef float f32x16 __attribute__((ext_vector_type(16)));
typedef unsigned u32x4 __attribute__((ext_vector_type(4)));
typedef unsigned u32x2 __attribute__((ext_vector_type(2)));
typedef GAS unsigned gu32;

constexpr int BATCH = 8, SEQ = 4096, DM = 1024, T = BATCH * SEQ;
constexpr int NMEM = 256, MT = BATCH * NMEM;
constexpr int DRNN = 512, DATT = 512, NH = 8, HD = 64, CHUNK = 64, NCHUNK = SEQ / CHUNK, LEFT = 8;
constexpr int DIN = 2 * DRNN + 3 * DATT;
constexpr int XH = 4, XD = 256;
constexpr int NE = 32, DE = 512, NGRP = 4, EPG = 8;
constexpr float EPS = 1e-6f;
constexpr int NWAVES = 8, NTHR = 512;

constexpr size_t MiB = 1u << 20;
constexpr size_t WS_CTL = 0, CTL_ZERO_BYTES = 1 * MiB;
constexpr size_t WS_RSTD1 = 1 * MiB;
constexpr size_t WS_SSQR = 2 * MiB;
constexpr size_t WS_SSQA = 6 * MiB;
constexpr size_t WS_SSQ1 = 7 * MiB;
constexpr size_t WS_SSQ2 = 9 * MiB;
constexpr size_t WS_SLOTW = 11 * MiB;
constexpr size_t WS_LIST = 12 * MiB;
constexpr size_t WS_WIN = 16 * MiB;
constexpr size_t WS_WKV = 21 * MiB;
constexpr size_t WS_WOUT = 25 * MiB;
constexpr size_t WS_WQ = 27 * MiB;
constexpr size_t WS_WO = 29 * MiB;
constexpr size_t WS_WR = 31 * MiB;
constexpr size_t WS_WGU = 32 * MiB;
constexpr size_t WS_WD = 96 * MiB;
constexpr size_t WS_XB = 128 * MiB;
constexpr size_t WS_PROJ = 192 * MiB;
constexpr size_t WS_X1 = 192 * MiB;
constexpr size_t WS_YSLOT = 192 * MiB;
constexpr size_t WS_HID = 320 * MiB;
constexpr size_t WS_YMIX = 352 * MiB;
constexpr size_t WS_QX = 352 * MiB;
constexpr size_t WS_MEMN = 416 * MiB;
constexpr size_t WS_O = 416 * MiB;
constexpr size_t WS_KV = 480 * MiB;
constexpr size_t WS_END = 488 * MiB;
constexpr int HID_ROWS = 2 * T + NE * 256;

constexpr int CW_CNT = 64;
constexpr int CW_BAR = 4096;

constexpr int RING_BYTES = 131072;
constexpr int LDS_TOK = RING_BYTES;
constexpr int LDS_MISC = RING_BYTES + 8192;
constexpr int LDS_BYTES = 147456;

#define RLX_AGENT __ATOMIC_RELAXED, __HIP_MEMORY_SCOPE_AGENT
#define LDS_WAIT() asm volatile("s_waitcnt lgkmcnt(0)" ::: "memory")
#define VM_WAIT() asm volatile("s_waitcnt vmcnt(0)" ::: "memory")

__device__ __forceinline__ int hw_lane() { return (int)__builtin_amdgcn_mbcnt_hi(~0u, __builtin_amdgcn_mbcnt_lo(~0u, 0u)); }
__device__ __forceinline__ unsigned f2bf(float f) { unsigned u = __builtin_bit_cast(unsigned, f); return (u + 0x7fffu + ((u >> 16) & 1u)) >> 16; }
__device__ __forceinline__ unsigned pk2(float lo, float hi) { return f2bf(lo) | (f2bf(hi) << 16); }
__device__ __forceinline__ float bf2f(unsigned short b) { return __builtin_bit_cast(float, (unsigned)b << 16); }
__device__ __forceinline__ float bflo(unsigned w) { return __builtin_bit_cast(float, w << 16); }
__device__ __forceinline__ float bfhi(unsigned w) { return __builtin_bit_cast(float, w & 0xffff0000u); }

namespace pg8 {
constexpr int BM = 256, BK = 64, HALF = 128, HTB = HALF * BK * 2, STAGE_BYTES = 8 * HTB, NXCD = 8, WGM = 8;
__host__ __device__ __forceinline__ int lds_byte(int r, int c) { const int st = (r >> 4) * 2 + (c >> 5), rr = r & 15, cc = c & 31, ob = rr * 64 + cc * 2; return st * 1024 + (ob ^ (((ob >> 9) & 1) << 5)); }
__host__ __device__ __forceinline__ void stage_rc(int b, int& R, int& C) { const int st = b / 1024, sb = b % 1024, swz = sb ^ (((sb >> 9) & 1) << 5); R = (st >> 1) * 16 + swz / 64; C = (st & 1) * 32 + (swz % 64) / 2; }
__host__ __device__ __forceinline__ int perm32(int rho) { const int n = rho >> 4, i = rho & 15; return 8 * (i >> 2) + 4 * n + (i & 3); }

struct Unit { int pm, pn, aux, idx; };

struct StaticOrder {
    int nM, nN, nwg, G, c;
    __device__ void init(int M, int N, int G_, int c_) { nM = M / BM; nN = N / BM; nwg = nM * nN; G = G_; c = c_; }
    __device__ bool next(int i, Unit& u) const {
        const long L = (long)i * G + c; if (L >= nwg) return false;
        int wgid = (int)L; { const int q = nwg / NXCD, r = nwg % NXCD, xcd = wgid % NXCD, off = wgid / NXCD; wgid = (xcd < r ? xcd * (q + 1) : r * (q + 1) + (xcd - r) * q) + off; }
        const int nig = WGM * nN, gid = wgid / nig, fm = gid * WGM, gsz = (nM - fm) < WGM ? (nM - fm) : WGM;
        u.pm = fm + ((wgid % nig) % gsz); u.pn = (wgid % nig) / gsz; u.aux = 0; u.idx = i; return true;
    }
};
struct TwoHalfOrder {
    StaticOrder s;
    __device__ bool next(int i, Unit& u) const { if (!s.next(i >> 1, u)) return false; u.aux = i & 1; u.idx = i; return true; }
};

__device__ __forceinline__ unsigned cvt_pk_bf16(float lo, float hi) { unsigned r; asm volatile("v_cvt_pk_bf16_f32 %0, %1, %2" : "=v"(r) : "v"(lo), "v"(hi)); return r; }

struct DenseG {
    const bf16* A; const bf16* Bt; int lda, ldb, nt, kaux;
    static constexpr bool GATHER = false;
    __device__ __forceinline__ const char* a_base(const Unit& u) const { return (const char*)(A + (size_t)u.pm * BM * lda + (size_t)u.aux * kaux); }
    __device__ __forceinline__ const char* b_base(const Unit& u) const { return (const char*)(Bt + (size_t)u.pn * BM * ldb + (size_t)u.aux * kaux); }
    __device__ __forceinline__ void a_voff(const Unit&, const int (&R)[2], const int (&C)[2], unsigned (&v)[2][2], const LAS int*) const {
#pragma unroll
        for (int h = 0; h < 2; ++h)
#pragma unroll
            for (int i = 0; i < 2; ++i) v[h][i] = (unsigned)((h * HALF + R[i]) * lda + C[i]) * 2u;
    }
};

template <class G, class Epi, class Sched, bool ALIGN_EPI>
__device__ __forceinline__ void gemm_phase(LAS unsigned char* lds, const LAS int* ltok, const G& g, const Sched& S, const Epi& E, int wave_id) {
    const int wid = __builtin_amdgcn_readfirstlane(wave_id), lane = hw_lane(), tid = wid * 64 + lane, wr = wid >> 2, wc = wid & 3, fr = lane & 15, fq = lane >> 4;
    const int nt = g.nt;
    int Rs[2], Cs[2]; unsigned voffB[2];
#pragma unroll
    for (int i = 0; i < 2; ++i) { stage_rc(tid * 16 + i * 8192, Rs[i], Cs[i]); const int Rb = Epi::PERM ? ((Rs[i] & ~31) + perm32(Rs[i] & 31)) : Rs[i];
        voffB[i] = (unsigned)(Rb * g.ldb + Cs[i]) * 2u; }
    const size_t kstep = (size_t)(BK * 2);
    const size_t hstepB = (size_t)HALF * g.ldb * 2;
    const unsigned ldsw = (unsigned)wid * 1024u;
    const int aoff = lds_byte(wr * 64 + fr, fq * 8), boff = lds_byte(wc * 32 + fr, fq * 8);
#define PG8_SA(b, h) (((b) * 2 + (h)) * HTB)
#define PG8_SB(b, h) ((4 + (b) * 2 + (h)) * HTB)
#define PG8_STAGE_A(bufoff, gbase, VO, h) do { _Pragma("unroll") for (int _i = 0; _i < 2; ++_i) \
        __builtin_amdgcn_global_load_lds((const unsigned*)((const char*)(gbase) + (VO)[h][_i]), (LAS unsigned*)(lds + (bufoff) + ldsw + _i * 8192), 16, 0, 0); } while (0)
#define PG8_STAGE_B(bufoff, gbase) do { _Pragma("unroll") for (int _i = 0; _i < 2; ++_i) \
        __builtin_amdgcn_global_load_lds((const unsigned*)((const char*)(gbase) + voffB[_i]), (LAS unsigned*)(lds + (bufoff) + ldsw + _i * 8192), 16, 0, 0); } while (0)
#define PG8_LDA(dst, b, h) do { _Pragma("unroll") for (int m = 0; m < 4; ++m) _Pragma("unroll") for (int k = 0; k < 2; ++k) dst[m][k] = *(const LAS bf16x8*)(lds + PG8_SA(b, h) + aoff + m * 2048 + k * 1024); } while (0)
#define PG8_LDB(dst, b, h) do { _Pragma("unroll") for (int n = 0; n < 2; ++n) _Pragma("unroll") for (int k = 0; k < 2; ++k) dst[n][k] = *(const LAS bf16x8*)(lds + PG8_SB(b, h) + boff + n * 2048 + k * 1024); } while (0)
#define PG8_MMA(ai, bj, At, Bt) do { __builtin_amdgcn_s_setprio(1); _Pragma("unroll") for (int m = 0; m < 4; ++m) _Pragma("unroll") for (int n = 0; n < 2; ++n) _Pragma("unroll") for (int k = 0; k < 2; ++k) \
        acc[ai][bj][m][n] = __builtin_amdgcn_mfma_f32_16x16x32_bf16(Bt[n][k], At[m][k], acc[ai][bj][m][n], 0, 0, 0); __builtin_amdgcn_s_setprio(0); } while (0)
#define PG8_WAIT_V(n) asm volatile("s_waitcnt vmcnt(" #n ")" ::: "memory")
#define PG8_WAIT_L(n) asm volatile("s_waitcnt lgkmcnt(" #n ")" ::: "memory")
#define PG8_BAR __builtin_amdgcn_s_barrier()
#define PG8_SCHED __builtin_amdgcn_sched_barrier(0)
    Unit cur, nxt; int ui = 0;
    if (!S.next(0, cur)) return;
    f32x4 acc[2][2][4][2];
#pragma unroll
    for (int a = 0; a < 2; ++a)
#pragma unroll
        for (int b = 0; b < 2; ++b)
#pragma unroll
            for (int m = 0; m < 4; ++m)
#pragma unroll
                for (int n = 0; n < 2; ++n) acc[a][b][m][n] = (f32x4){0.f, 0.f, 0.f, 0.f};
    bf16x8 At[4][2], B0[2][2], B1[2][2];
    unsigned voAc[2][2], voAn[2][2];
    g.a_voff(cur, Rs, Cs, voAc, ltok);
    const char* cA = g.a_base(cur); const char* cB = g.b_base(cur);
    PG8_STAGE_B(PG8_SB(0, 0), cB); PG8_STAGE_B(PG8_SB(0, 1), cB + hstepB); PG8_STAGE_A(PG8_SA(0, 0), cA, voAc, 0); PG8_STAGE_A(PG8_SA(0, 1), cA, voAc, 1);
    if (wr == 1) PG8_BAR;
    PG8_WAIT_V(2); PG8_BAR;
    PG8_STAGE_B(PG8_SB(1, 0), cB + kstep); PG8_STAGE_A(PG8_SA(1, 0), cA + kstep, voAc, 0); PG8_STAGE_B(PG8_SB(1, 1), cB + hstepB + kstep);
    PG8_WAIT_V(6); PG8_BAR;
    for (;;) {
        const bool has_next = S.next(ui + 1, nxt);
        const char* nA = cA; const char* nB = cB;
        if (has_next) { nA = g.a_base(nxt); nB = g.b_base(nxt); g.a_voff(nxt, Rs, Cs, voAn, ltok); }
        else {
#pragma unroll
            for (int h = 0; h < 2; ++h)
#pragma unroll
                for (int i = 0; i < 2; ++i) voAn[h][i] = voAc[h][i]; }
        for (int t = 0; t < nt; t += 2) {
            const bool last = (t == nt - 2);
            const char* a1 = cA + (size_t)(t + 1) * kstep;
            const char* a2 = last ? nA : cA + (size_t)(t + 2) * kstep; const char* b2 = last ? nB : cB + (size_t)(t + 2) * kstep;
            const char* a3 = a2 + kstep; const char* b3 = b2 + kstep;
            unsigned vo2[2][2];
#pragma unroll
            for (int h = 0; h < 2; ++h)
#pragma unroll
                for (int i = 0; i < 2; ++i) vo2[h][i] = last ? voAn[h][i] : voAc[h][i];
            PG8_LDB(B0, 0, 0); PG8_LDB(B1, 0, 1); PG8_SCHED; PG8_LDA(At, 0, 0); PG8_STAGE_A(PG8_SA(1, 1), a1, voAc, 1);
            PG8_WAIT_V(8); PG8_WAIT_L(0); PG8_BAR; PG8_MMA(0, 0, At, B0); PG8_MMA(0, 1, At, B1); PG8_BAR; PG8_SCHED;
            PG8_LDA(At, 0, 1); PG8_STAGE_B(PG8_SB(0, 0), b2); PG8_STAGE_B(PG8_SB(0, 1), b2 + hstepB); PG8_STAGE_A(PG8_SA(0, 0), a2, vo2, 0);
            PG8_WAIT_V(8); PG8_WAIT_L(0); PG8_BAR; PG8_MMA(1, 0, At, B0); PG8_MMA(1, 1, At, B1); PG8_BAR; PG8_SCHED;
            PG8_LDB(B0, 1, 0); PG8_LDB(B1, 1, 1); PG8_SCHED; PG8_LDA(At, 1, 0); PG8_STAGE_A(PG8_SA(0, 1), a2, vo2, 1);
            PG8_WAIT_V(8); PG8_WAIT_L(0); PG8_BAR; PG8_MMA(0, 0, At, B0); PG8_MMA(0, 1, At, B1); PG8_BAR; PG8_SCHED;
            PG8_LDA(At, 1, 1); PG8_STAGE_B(PG8_SB(1, 0), b3); PG8_STAGE_B(PG8_SB(1, 1), b3 + hstepB); PG8_STAGE_A(PG8_SA(1, 0), a3, vo2, 0);
            PG8_WAIT_V(8); PG8_WAIT_L(0); PG8_BAR; PG8_MMA(1, 0, At, B0); PG8_MMA(1, 1, At, B1); PG8_BAR; PG8_SCHED;
        }
        if constexpr (ALIGN_EPI) { if (wr == 0) PG8_BAR; }
        const bool keep = E(acc, cur, wr, wc, fr, fq);
        if (!has_next) break;
        if (!keep) {
#pragma unroll
            for (int a = 0; a < 2; ++a)
#pragma unroll
                for (int b = 0; b < 2; ++b)
#pragma unroll
                    for (int m = 0; m < 4; ++m)
#pragma unroll
                        for (int n = 0; n < 2; ++n) acc[a][b][m][n] = (f32x4){0.f, 0.f, 0.f, 0.f};
        }
        cur = nxt; cA = nA; cB = nB; ++ui;
#pragma unroll
        for (int h = 0; h < 2; ++h)
#pragma unroll
            for (int i = 0; i < 2; ++i) voAc[h][i] = voAn[h][i];
        if constexpr (ALIGN_EPI) { if (wr == 1) PG8_BAR; }
    }
    PG8_WAIT_V(0);
    if constexpr (!ALIGN_EPI) { if (wr == 0) PG8_BAR; }
    PG8_BAR;
#undef PG8_SA
#undef PG8_SB
#undef PG8_STAGE_A
#undef PG8_STAGE_B
#undef PG8_LDA
#undef PG8_LDB
#undef PG8_MMA
#undef PG8_WAIT_V
#undef PG8_WAIT_L
#undef PG8_BAR
#undef PG8_SCHED
}
}

#define XB_TMO      128
#define XB_XCNT(j)  (256  + 64 * (j))
#define XB_XSUB(j)  (1280 + 64 * (j))
#define XB_XGEN(j)  (2304 + 64 * (j))
#define XB_TOP      3328
#define XB_TOPGEN   3392
#define XCD_BAR_WORDS 3456
#define XB_SPIN_CAP (1u << 18)
__device__ __forceinline__ unsigned xb_ld(unsigned* p)              { return __hip_atomic_load(p, __ATOMIC_RELAXED, __HIP_MEMORY_SCOPE_AGENT); }
__device__ __forceinline__ unsigned xb_add(unsigned* p, unsigned v) { return __hip_atomic_fetch_add(p, v, __ATOMIC_RELAXED, __HIP_MEMORY_SCOPE_AGENT); }
__device__ __forceinline__ unsigned xb_xcc_id() { return (unsigned)__builtin_amdgcn_s_getreg((3 << 11) | 20) & 0xFu; }
#define XB_SPIN(cond, bar) do { unsigned _sp = 0; while (cond) { __builtin_amdgcn_s_sleep(1); \
    if ((++_sp & 255u) == 0u) { if (xb_ld(&(bar)[XB_TMO])) break; if (_sp > XB_SPIN_CAP) { atomicAdd(&(bar)[XB_TMO], 1u); break; } } } } while (0)
struct XcdBarrier { unsigned* bar; unsigned x; volatile LAS unsigned* st; int w; };
__device__ __forceinline__ XcdBarrier xcd_barrier_post(unsigned* bar, volatile LAS unsigned* st, int wave_id) {
    XcdBarrier b; b.bar = bar; b.x = xb_xcc_id(); b.st = st; b.w = wave_id;
    if (wave_id == 0 && hw_lane() == 0) (void)xb_add(&bar[XB_XCNT(b.x)], 1u);
    return b;
}
__device__ __forceinline__ void xcd_barrier_complete(unsigned* bar, unsigned x, unsigned& nloc, unsigned& nx) {
    const unsigned G = gridDim.x * gridDim.y * gridDim.z;
    unsigned sum, cnt, mine, sp = 0u;
    for (;;) {
        sum = 0u; cnt = 0u; mine = 0u;
#pragma unroll
        for (unsigned j = 0; j < 16; ++j) { const unsigned c = xb_ld(&bar[XB_XCNT(j)]); sum += c; cnt += (c > 0u) ? 1u : 0u; mine = (j == x) ? c : mine; }
        if (sum == G) break;
        __builtin_amdgcn_s_sleep(1);
        if ((++sp & 255u) == 0u) { if (xb_ld(&bar[XB_TMO])) break; if (sp > XB_SPIN_CAP) { atomicAdd(&bar[XB_TMO], 1u); break; } }
    }
    nloc = mine > 0u ? mine : 1u; nx = cnt > 0u ? cnt : 1u;
}
__device__ __forceinline__ void xcd_barrier(const XcdBarrier& b) {
    asm volatile("s_waitcnt vmcnt(0)" ::: "memory");
    __syncthreads();
    if (b.w == 0 && hw_lane() == 0) {
        unsigned* bar = b.bar;
        __builtin_amdgcn_s_waitcnt(0);
        unsigned nloc = b.st[0], nx = b.st[1];
        if (nloc == 0u) { xcd_barrier_complete(bar, b.x, nloc, nx); b.st[0] = nloc; b.st[1] = nx; }
        const unsigned old = xb_add(&bar[XB_XSUB(b.x)], 1u);
        const unsigned gen = old / nloc;
        if (old + 1u == (gen + 1u) * nloc) {
            __builtin_amdgcn_fence(__ATOMIC_RELEASE, "agent");
            asm volatile("s_waitcnt vmcnt(0)" ::: "memory");
            const unsigned og = xb_add(&bar[XB_TOP], 1u);
            const unsigned tg = og / nx;
            if (og + 1u == (tg + 1u) * nx) xb_add(&bar[XB_TOPGEN], 1u);
            else XB_SPIN(xb_ld(&bar[XB_TOPGEN]) == tg, bar);
            __builtin_amdgcn_fence(__ATOMIC_ACQUIRE, "agent");
            xb_add(&bar[XB_XGEN(b.x)], 1u);
            asm volatile("s_waitcnt vmcnt(0)" ::: "memory");
        } else {
            XB_SPIN(xb_ld(&bar[XB_XGEN(b.x)]) == gen, bar);
            __builtin_amdgcn_fence(__ATOMIC_ACQUIRE, "agent");
            asm volatile("s_waitcnt vmcnt(0)" ::: "memory");
        }
    }
    __syncthreads();
}

struct Args { const float* in[30]; float* out; unsigned char* ws; int ph_lo, ph_hi; };
struct Frame {
    LAS unsigned char* lds;
    int tid, lane, wave, vcu, G;
    const float* const* in;
    unsigned char* ws; float* out;
};
__device__ __forceinline__ float wave_sum(float v) {
#pragma unroll
    for (int o = 1; o < 64; o <<= 1) v += __shfl_xor(v, o);
    return v;
}

__device__ __forceinline__ void p0_tr_item(const float* W, int N, int k0, int n0, const float* sk, float cs, bf16* WT, int ldt, int drow0, LAS unsigned char* scr, int lane) {
    const int n4 = lane & 15, kq = lane >> 4;
    f32x4 v[16];
#pragma unroll
    for (int i = 0; i < 16; ++i) v[i] = *(const f32x4*)(W + (size_t)(k0 + kq + 4 * i) * N + n0 + 4 * n4);
#pragma unroll
    for (int i = 0; i < 16; ++i) { const float sc = (sk ? sk[k0 + kq + 4 * i] : 1.0f) * cs; u32x2 w; w.x = pk2(v[i].x * sc, v[i].y * sc); w.y = pk2(v[i].z * sc, v[i].w * sc);
        *(LAS u32x2*)(scr + (kq + 4 * i) * 128 + n4 * 8) = w; }
    LDS_WAIT(); asm volatile("" ::: "memory");
    const int g = lane >> 4, li = lane & 15;
    const LAS unsigned char* rp = scr + (li >> 2) * 128 + (16 * g + 4 * (li & 3)) * 2;
    bf16* op = WT + (size_t)(drow0 + 16 * g + li) * ldt + k0;
#pragma unroll
    for (int c = 0; c < 8; ++c) {
        const s16x4 a = __builtin_bit_cast(s16x4, __builtin_amdgcn_ds_read_tr16_b64_v4i16((LAS s16x4*)(rp + (8 * c) * 128)));
        const s16x4 b = __builtin_bit_cast(s16x4, __builtin_amdgcn_ds_read_tr16_b64_v4i16((LAS s16x4*)(rp + (8 * c + 4) * 128)));
        *(bf16x8*)(op + 8 * c) = (bf16x8){a[0], a[1], a[2], a[3], b[0], b[1], b[2], b[3]};
    }
    LDS_WAIT(); asm volatile("" ::: "memory");
}
__device__ __forceinline__ void p0_prologue(Frame& F) {
    LAS unsigned char* scr = F.lds + F.wave * 8192;
    const int gw = F.vcu * NWAVES + F.wave, NGW = F.G * NWAVES, lane = F.lane;
    unsigned char* ws = F.ws;
    bf16* WinT = (bf16*)(ws + WS_WIN); bf16* WkvT = (bf16*)(ws + WS_WKV); bf16* WoutT = (bf16*)(ws + WS_WOUT); bf16* WqT = (bf16*)(ws + WS_WQ);
    bf16* WoT = (bf16*)(ws + WS_WO); bf16* WguT = (bf16*)(ws + WS_WGU); bf16* WdT = (bf16*)(ws + WS_WD);
    constexpr int I_IN = 16 * 40, I_SQ = 16 * 16, I_GU = NE * 16 * 8, I_D = NE * 8 * 16;
    constexpr int NITEMS = I_IN + 5 * I_SQ + 2 * I_GU + I_D;
    for (int it = gw; it < NITEMS; it += NGW) {
        int r = it;
        if (r < I_IN) { const int kb = r / 40, nb = r % 40, n0 = nb * 64; const float cs = (n0 >= 1024 && n0 < 1536) ? 0.125f : 1.0f;
            p0_tr_item(F.in[3], DIN, kb * 64, n0, F.in[2], cs, WinT, DM, n0, scr, lane); continue; } r -= I_IN;
        if (r < I_SQ) { const int kb = r / 16, nb = r % 16; const float* sk = (kb < 8) ? F.in[12] : (F.in[13] - 512);
            p0_tr_item(F.in[14], DM, kb * 64, nb * 64, sk, 1.0f, WoutT, DM, nb * 64, scr, lane); continue; } r -= I_SQ;
        if (r < I_SQ) { const int kb = r / 16, nb = r % 16; p0_tr_item(F.in[17], DM, kb * 64, nb * 64, F.in[15], 0.0625f, WqT, DM, nb * 64, scr, lane); continue; } r -= I_SQ;
        if (r < I_SQ) { const int kb = r / 16, nb = r % 16; p0_tr_item(F.in[18], DM, kb * 64, nb * 64, nullptr, 1.0f, WkvT, DM, nb * 64, scr, lane); continue; } r -= I_SQ;
        if (r < I_SQ) { const int kb = r / 16, nb = r % 16; p0_tr_item(F.in[19], DM, kb * 64, nb * 64, nullptr, 1.0f, WkvT, DM, 1024 + nb * 64, scr, lane); continue; } r -= I_SQ;
        if (r < I_SQ) { const int kb = r / 16, nb = r % 16; p0_tr_item(F.in[20], DM, kb * 64, nb * 64, nullptr, 1.0f, WoT, DM, nb * 64, scr, lane); continue; } r -= I_SQ;
        if (r < 2 * I_GU) { const int up = r / I_GU; r -= up * I_GU; const int e = r / 128, q = r % 128, kb = q / 8, nb = q % 8, n0 = nb * 64;
            const int drow = (n0 >> 7) * 256 + up * 128 + (n0 & 127);
            p0_tr_item(F.in[26 + up] + (size_t)e * DM * DE, DE, kb * 64, n0, F.in[21], 1.0f, WguT + (size_t)e * 1024 * 1024, DM, drow, scr, lane); continue; } r -= 2 * I_GU;
        { const int e = r / 128, q = r % 128, kb = q / 16, nb = q % 16;
            p0_tr_item(F.in[28] + (size_t)e * DE * DM, DM, kb * 64, nb * 64, nullptr, 1.0f, WdT + (size_t)e * 1024 * 512, DE, nb * 64, scr, lane); }
    }
    bf16* XB = (bf16*)(ws + WS_XB); float* rstd1 = (float*)(ws + WS_RSTD1); bf16* MEMN = (bf16*)(ws + WS_MEMN);
    f32x4 nx[4];
    {
        const int m = gw;
        if (m < T + MT) { const f32x4* xr = (const f32x4*)((m < T ? F.in[0] : F.in[1]) + (size_t)(m < T ? m : m - T) * DM) + lane;
#pragma unroll
            for (int j = 0; j < 4; ++j) nx[j] = xr[64 * j]; }
    }
    for (int m = gw; m < T + MT; m += NGW) {
        const bool isx = m < T; const int row = isx ? m : m - T;
        f32x4 v[4]; float s = 0.f;
#pragma unroll
        for (int j = 0; j < 4; ++j) v[j] = nx[j];
        const int m2 = m + NGW;
        if (m2 < T + MT) { const f32x4* xr = (const f32x4*)((m2 < T ? F.in[0] : F.in[1]) + (size_t)(m2 < T ? m2 : m2 - T) * DM) + lane;
#pragma unroll
            for (int j = 0; j < 4; ++j) nx[j] = xr[64 * j]; }
#pragma unroll
        for (int j = 0; j < 4; ++j) s += (v[j].x * v[j].x + v[j].y * v[j].y) + (v[j].z * v[j].z + v[j].w * v[j].w);
        const float rstd = 1.0f / sqrtf(wave_sum(s) * (1.0f / DM) + EPS);
        unsigned long long* o8 = (unsigned long long*)((isx ? XB : MEMN) + (size_t)row * DM) + lane;
        if (isx) { if (lane == 0) rstd1[row] = rstd;
#pragma unroll
            for (int j = 0; j < 4; ++j) o8[64 * j] = (unsigned long long)pk2(v[j].x, v[j].y) | ((unsigned long long)pk2(v[j].z, v[j].w) << 32);
        } else { const f32x4* wv = (const f32x4*)F.in[16] + lane;
#pragma unroll
            for (int j = 0; j < 4; ++j) { const f32x4 w = wv[64 * j]; o8[64 * j] = (unsigned long long)pk2(v[j].x * rstd * w.x, v[j].y * rstd * w.y) | ((unsigned long long)pk2(v[j].z * rstd * w.z, v[j].w * rstd * w.w) << 32); }
        }
    }
    bf16* WrT = (bf16*)(ws + WS_WR);
    for (int i = (F.vcu * NTHR + F.tid); i < 64 * DM; i += F.G * NTHR) {
        const int n = i / DM, k = i % DM; float v = 0.f;
        if (n < 4) v = F.in[22][k * 4 + n]; else if (n < 36) { const int gg = (n - 4) >> 3, e = (n - 4) & 7; v = F.in[24][((size_t)gg * DM + k) * 8 + e]; }
        WrT[i] = (bf16)f2bf(v * F.in[21][k]);
    }
}

struct RsNone { __device__ __forceinline__ float operator()(int) const { return 1.0f; } };
struct RsArr { const float* p; __device__ __forceinline__ float operator()(int r) const { return p[r]; } };
struct RsPart16 { const float* p; __device__ __forceinline__ float operator()(int r) const { const f32x4* q = (const f32x4*)(p + (size_t)r * 16); const f32x4 a = q[0], b = q[1], c = q[2], d = q[3];
    const float s = ((a.x + a.y) + (a.z + a.w)) + ((b.x + b.y) + (b.z + b.w)) + ((c.x + c.y) + (c.z + c.w)) + ((d.x + d.y) + (d.z + d.w)); return 1.0f / sqrtf(s * (1.0f / DM) + EPS); } };

template <class RS> struct EpiBf16 {
    static constexpr bool PERM = true;
    bf16* O; int ldc; RS rs;
    __device__ __forceinline__ bool operator()(f32x4 (&acc)[2][2][4][2], const pg8::Unit& u, int wr, int wc, int fr, int fq) const {
        const int row0 = u.pm * 256 + wr * 64 + fr, col0 = u.pn * 256 + wc * 32 + 8 * fq;
#pragma unroll
        for (int ai = 0; ai < 2; ++ai)
#pragma unroll
            for (int m = 0; m < 4; ++m) { const int row = row0 + ai * 128 + m * 16; const float s = rs(row); bf16* rowp = O + (size_t)row * ldc + col0;
#pragma unroll
                for (int bj = 0; bj < 2; ++bj) { const f32x4 v0 = acc[ai][bj][m][0] * s, v1 = acc[ai][bj][m][1] * s; u32x4 w;
                    w.x = pg8::cvt_pk_bf16(v0[0], v0[1]); w.y = pg8::cvt_pk_bf16(v0[2], v0[3]); w.z = pg8::cvt_pk_bf16(v1[0], v1[1]); w.w = pg8::cvt_pk_bf16(v1[2], v1[3]);
                    *(u32x4*)(rowp + bj * 128) = w; } }
        return false;
    }
};

template <bool MIX, bool RESBF> struct EpiRes {
    static constexpr bool PERM = true;
    const float* resf; bf16* xb; float* ssq;
    const LAS float* stab;
    __device__ __forceinline__ bool operator()(f32x4 (&acc)[2][2][4][2], const pg8::Unit& u, int wr, int wc, int fr, int fq) const {
        const int rt0 = wr * 64 + fr, row0 = u.pm * 256 + rt0, col0 = u.pn * 256 + wc * 32 + 8 * fq;
        const LAS float* st = stab + ((u.idx >> 1) & 3) * 512;
        if (MIX && u.aux == 0) {
#pragma unroll
            for (int ai = 0; ai < 2; ++ai)
#pragma unroll
                for (int m = 0; m < 4; ++m) { const float q = st[(rt0 + ai * 128 + m * 16) * 2];
#pragma unroll
                    for (int bj = 0; bj < 2; ++bj)
#pragma unroll
                        for (int n = 0; n < 2; ++n) acc[ai][bj][m][n] = acc[ai][bj][m][n] * q; }
            return true;
        }
#pragma unroll
        for (int ai = 0; ai < 2; ++ai)
#pragma unroll
            for (int m = 0; m < 4; ++m) { const int row = row0 + ai * 128 + m * 16; float s = 1.0f;
                if (MIX) s = st[(rt0 + ai * 128 + m * 16) * 2 + 1];
                const size_t off = (size_t)row * DM + col0; float q = 0.f;
#pragma unroll
                for (int bj = 0; bj < 2; ++bj) { f32x4 r0, r1;
                    if (RESBF) { const u32x4 rw = *(const u32x4*)(xb + off + bj * 128); r0 = (f32x4){bflo(rw.x), bfhi(rw.x), bflo(rw.y), bfhi(rw.y)}; r1 = (f32x4){bflo(rw.z), bfhi(rw.z), bflo(rw.w), bfhi(rw.w)}; }
                    else { r0 = *(const f32x4*)(resf + off + bj * 128); r1 = *(const f32x4*)(resf + off + bj * 128 + 4); }
                    const f32x4 v0 = r0 + acc[ai][bj][m][0] * s, v1 = r1 + acc[ai][bj][m][1] * s; u32x4 w;
                    w.x = pg8::cvt_pk_bf16(v0[0], v0[1]); w.y = pg8::cvt_pk_bf16(v0[2], v0[3]); w.z = pg8::cvt_pk_bf16(v1[0], v1[1]); w.w = pg8::cvt_pk_bf16(v1[2], v1[3]);
                    *(u32x4*)(xb + off + bj * 128) = w;
                    q += ((v0[0] * v0[0] + v0[1] * v0[1]) + (v0[2] * v0[2] + v0[3] * v0[3])) + ((v1[0] * v1[0] + v1[1] * v1[1]) + (v1[2] * v1[2] + v1[3] * v1[3])); }
                q += __shfl_xor(q, 16); q += __shfl_xor(q, 32);
                if (fq == 0) ssq[(size_t)row * 16 + u.pn * 4 + wc] = q; }
        return false;
    }
};
__device__ __forceinline__ void p3_scale_table(Frame& F, const pg8::StaticOrder& S, LAS float* stab) {
    const float* ssqr = (const float*)(F.ws + WS_SSQR); const float* ssqa = (const float*)(F.ws + WS_SSQA);
    pg8::Unit u;
    for (int i = 0; i < 4 && S.next(i, u); ++i) {
        if (F.tid < 256) { const int row = u.pm * 256 + F.tid; float sr = 0.f, sa = 0.f;
#pragma unroll 8
            for (int j = 0; j < 32; ++j) sr += ssqr[(size_t)j * T + row];
#pragma unroll
            for (int j = 0; j < 8; ++j) sa += ssqa[(size_t)j * T + row];
            const float rr = 1.0f / sqrtf(sr * (1.0f / DRNN) + EPS), ra = 1.0f / sqrtf(sa * (1.0f / DATT) + EPS);
            stab[(i * 256 + F.tid) * 2] = rr / ra; stab[(i * 256 + F.tid) * 2 + 1] = ra; }
    }
    __syncthreads();
}

struct MoeTab { int mt_pref[NE + 1]; };
struct MoeOrder {
    const LAS int* pref;
    int G, c, ntile;
    __device__ __forceinline__ bool next(int i, pg8::Unit& u) const {
        const int xcd = c & 7, slot = c >> 3, nsl = G >> 3;
        const int tl = (i * 8 + xcd) * (nsl >> 2) + (slot >> 2); if (tl >= ntile) return false;
        u.pn = slot & 3;
        int e = 0;
#pragma unroll
        for (int j = 1; j < NE; ++j) e += (pref[j] <= tl) ? 1 : 0;
        u.aux = e; u.pm = tl; u.idx = i; return true;
    }
};
struct GatherG {
    const bf16* A; const bf16* Bt; int lda, ldb, nt;
    static constexpr bool GATHER = true;
    __device__ __forceinline__ const char* a_base(const pg8::Unit&) const { return (const char*)A; }
    __device__ __forceinline__ const char* b_base(const pg8::Unit& u) const { return (const char*)(Bt + ((size_t)u.aux * 1024 + (size_t)u.pn * 256) * ldb); }
    __device__ __forceinline__ void a_voff(const pg8::Unit& u, const int (&R)[2], const int (&C)[2], unsigned (&v)[2][2], const LAS int* ltok) const {
#pragma unroll
        for (int h = 0; h < 2; ++h)
#pragma unroll
            for (int i = 0; i < 2; ++i) { const int tok = ltok[(u.idx & 7) * 256 + h * 128 + R[i]] >> 1; v[h][i] = (unsigned)(tok * lda + C[i]) * 2u; }
    }
};
struct DownG {
    const bf16* A; const bf16* Bt; int lda, ldb, nt;
    static constexpr bool GATHER = false;
    __device__ __forceinline__ const char* a_base(const pg8::Unit& u) const { return (const char*)(A + (size_t)u.pm * 256 * lda); }
    __device__ __forceinline__ const char* b_base(const pg8::Unit& u) const { return (const char*)(Bt + ((size_t)u.aux * 1024 + (size_t)u.pn * 256) * ldb); }
    __device__ __forceinline__ void a_voff(const pg8::Unit&, const int (&R)[2], const int (&C)[2], unsigned (&v)[2][2], const LAS int*) const {
#pragma unroll
        for (int h = 0; h < 2; ++h)
#pragma unroll
            for (int i = 0; i < 2; ++i) v[h][i] = (unsigned)((h * 128 + R[i]) * lda + C[i]) * 2u;
    }
};
struct EpiGateUp {
    static constexpr bool PERM = true;
    bf16* H; const LAS int* ltok; RsPart16 rs;
    __device__ __forceinline__ bool operator()(f32x4 (&acc)[2][2][4][2], const pg8::Unit& u, int wr, int wc, int fr, int fq) const {
        const int rt0 = wr * 64 + fr, row0 = u.pm * 256 + rt0, col0 = u.pn * 128 + wc * 32 + 8 * fq;
#pragma unroll
        for (int ai = 0; ai < 2; ++ai)
#pragma unroll
            for (int m = 0; m < 4; ++m) { bf16* rowp = H + (size_t)(row0 + ai * 128 + m * 16) * DE + col0; float h[8];
                int sl = ltok[(u.idx & 7) * 256 + rt0 + ai * 128 + m * 16]; sl = sl < 0 ? 0 : sl; const float rstd = rs(sl >> 1);
#pragma unroll
                for (int n = 0; n < 2; ++n)
#pragma unroll
                    for (int j = 0; j < 4; ++j) { const float gv = acc[ai][0][m][n][j] * rstd, uv = acc[ai][1][m][n][j] * rstd; h[n * 4 + j] = gv / (1.0f + __expf(-gv)) * uv; }
                u32x4 w; w.x = pg8::cvt_pk_bf16(h[0], h[1]); w.y = pg8::cvt_pk_bf16(h[2], h[3]); w.z = pg8::cvt_pk_bf16(h[4], h[5]); w.w = pg8::cvt_pk_bf16(h[6], h[7]);
                *(u32x4*)rowp = w; }
        return false;
    }
};
struct EpiDown {
    static constexpr bool PERM = true;
    bf16* Y; const float* slotw; const LAS int* ltok;
    __device__ __forceinline__ bool operator()(f32x4 (&acc)[2][2][4][2], const pg8::Unit& u, int wr, int wc, int fr, int fq) const {
        const int col0 = u.pn * 256 + wc * 32 + 8 * fq;
#pragma unroll
        for (int ai = 0; ai < 2; ++ai)
#pragma unroll
            for (int m = 0; m < 4; ++m) { const int slot = ltok[(u.idx & 7) * 256 + ai * 128 + wr * 64 + m * 16 + fr];
                if (slot >= 0) { const float s = slotw[slot]; bf16* rowp = Y + (size_t)slot * DM + col0;
#pragma unroll
                    for (int bj = 0; bj < 2; ++bj) { const f32x4 v0 = acc[ai][bj][m][0] * s, v1 = acc[ai][bj][m][1] * s; u32x4 w;
                        w.x = pg8::cvt_pk_bf16(v0[0], v0[1]); w.y = pg8::cvt_pk_bf16(v0[2], v0[3]); w.z = pg8::cvt_pk_bf16(v1[0], v1[1]); w.w = pg8::cvt_pk_bf16(v1[2], v1[3]);
                        *(u32x4*)(rowp + bj * 128) = w; } } }
        return false;
    }
};

__device__ __forceinline__ float sigmoidf_(float x) { return 1.0f / (1.0f + __expf(-x)); }
__device__ __forceinline__ float gelu_tanh(float x) { const float u = 0.7978845608028654f * (x + 0.044715f * x * x * x); return 0.5f * x * (1.0f + tanhf(u)); }

constexpr int RT = 256;
constexpr int RB_XR = 0;
constexpr int RB_XG = 37376;
constexpr int RB_SIZE = 45568;
constexpr int R_AGG = 2 * RB_SIZE;
constexpr int R_BW = R_AGG + 2048;
__device__ __forceinline__ float fast_sigmoid(float x) { return __builtin_amdgcn_rcpf(1.0f + __expf(-x)); }
__device__ __forceinline__ void rnn_item(Frame& F, int item) {
    const int b = item >> 5, cb = (item >> 2) & 7, sl = item & 3;
    const int tid = F.tid, lane = F.lane, wave = F.wave;
    LAS unsigned char* lds = F.lds;
    const bf16* proj = (const bf16*)(F.ws + WS_PROJ);
    bf16* ymix = (bf16*)(F.ws + WS_YMIX); float* ssqr = (float*)(F.ws + WS_SSQR);
    const int d = lane & 15, q4 = lane >> 4;
    const int chd = cb * 64 + sl * 16 + d;
    float cbr = F.in[7][chd], cbi = F.in[9][chd];
    __syncthreads();
    {
        const float* wa = F.in[6] + (size_t)cb * 64 * 64 + sl * 16 + d; const float* wx = F.in[8] + (size_t)cb * 64 * 64 + sl * 16 + d;
        const int gsel = wave >> 2, jj = wave & 3; const float* wsel = gsel ? wx : wa;
#pragma unroll
        for (int ks = 0; ks < 2; ++ks) { bf16x8 fr;
#pragma unroll
            for (int j = 0; j < 8; ++j) { const int c = 32 * ks + 8 * q4 + j; fr[j] = (short)f2bf(F.in[4][jj * DRNN + cb * 64 + c] * wsel[c * 64]); }
            *(LAS bf16x8*)(lds + R_BW + (((gsel * 4 + jj) * 2 + ks) * 64 + lane) * 16) = fr; }
        for (int c = 0; c < 64; ++c) { const float cbv = F.in[5][cb * 64 + c]; cbr += cbv * wa[c * 64]; cbi += cbv * wx[c * 64]; }
    }
    float cwd[4]; const float cbd = F.in[5][chd];
#pragma unroll
    for (int jj = 0; jj < 4; ++jj) cwd[jj] = F.in[4][jj * DRNN + chd];
    const float spc = -8.0f * log1pf(__expf(-F.in[10][chd]));
    float tcarry = 0.f;
    const bf16* xrbase = proj + (size_t)b * SEQ * DIN + cb * 64;
    const bf16* xgbase = proj + (size_t)b * SEQ * DIN + DRNN + cb * 64 + sl * 16;
    u32x4 pf[5], pg;
    auto issue = [&](int t0) {
#pragma unroll
        for (int k = 0; k < 5; ++k) { const int p = tid + 512 * k; const int row = p >> 3, c8 = p & 7; const int tk = t0 - 3 + row;
            pf[k] = (u32x4){0u, 0u, 0u, 0u};
            if ((k < 4 || tid < 24) && tk >= 0) pf[k] = *(const u32x4*)(xrbase + (size_t)tk * DIN + c8 * 8); }
        pg = *(const u32x4*)(xgbase + (size_t)(t0 + (tid >> 1)) * DIN + (tid & 1) * 8);
    };
    auto commit = [&](LAS unsigned char* buf) {
#pragma unroll
        for (int k = 0; k < 5; ++k) { const int p = tid + 512 * k; const int row = p >> 3, c8 = p & 7;
            if (k < 4 || tid < 24) *(LAS u32x4*)(buf + RB_XR + row * 144 + c8 * 16) = pf[k]; }
        *(LAS u32x4*)(buf + RB_XG + (tid >> 1) * 32 + (tid & 1) * 16) = pg;
    };
    issue(0); commit(lds);
    __syncthreads();
    for (int tile = 0; tile < SEQ / RT; ++tile) {
        const int t0 = tile * RT, cur = tile & 1;
        LAS unsigned char* buf = lds + cur * RB_SIZE;
        if (tile + 1 < SEQ / RT) issue(t0 + RT);
        float Pt[2][4], hl[2][4], gx[2][4];
        float Ac = 1.f, Hc = 0.f;
#pragma unroll
        for (int rt = 0; rt < 2; ++rt) {
            const int tb = 32 * wave + 16 * rt;
            f32x4 cr = {0.f, 0.f, 0.f, 0.f}, ci = {0.f, 0.f, 0.f, 0.f};
#pragma unroll
            for (int jj = 0; jj < 4; ++jj)
#pragma unroll
                for (int ks = 0; ks < 2; ++ks) { const bf16x8 a = *(const LAS bf16x8*)(buf + RB_XR + (tb + d + jj) * 144 + (32 * ks + 8 * q4) * 2);
                    const bf16x8 fa = *(const LAS bf16x8*)(lds + R_BW + ((jj * 2 + ks) * 64 + lane) * 16), fx = *(const LAS bf16x8*)(lds + R_BW + (((4 + jj) * 2 + ks) * 64 + lane) * 16);
                    cr = __builtin_amdgcn_mfma_f32_16x16x32_bf16(a, fa, cr, 0, 0, 0); ci = __builtin_amdgcn_mfma_f32_16x16x32_bf16(a, fx, ci, 0, 0, 0); }
            float xr7[7];
#pragma unroll
            for (int r = 0; r < 7; ++r) xr7[r] = bf2f(*(const LAS unsigned short*)(buf + RB_XR + (tb + 4 * q4 + r) * 144 + (sl * 16 + d) * 2));
            float av[4], uv[4];
#pragma unroll
            for (int j = 0; j < 4; ++j) { const float xc = cbd + cwd[0] * xr7[j] + cwd[1] * xr7[j + 1] + cwd[2] * xr7[j + 2] + cwd[3] * xr7[j + 3];
                const float r = fast_sigmoid(cr[j] + cbr), ig = fast_sigmoid(ci[j] + cbi); const float a = __expf(spc * r);
                av[j] = a; uv[j] = __builtin_amdgcn_sqrtf(fmaxf(1.0f - a * a, 0.f)) * (ig * xc);
                const float xg = bf2f(*(const LAS unsigned short*)(buf + RB_XG + (tb + 4 * q4 + j) * 32 + d * 2));
                const float uu = 0.7978845608028654f * (xg + 0.044715f * xg * xg * xg); gx[rt][j] = xg * __builtin_amdgcn_rcpf(1.0f + __expf(-2.0f * uu)); }
            float p[4], h[4];
            p[0] = av[0]; h[0] = uv[0];
#pragma unroll
            for (int j = 1; j < 4; ++j) { p[j] = av[j] * p[j - 1]; h[j] = av[j] * h[j - 1] + uv[j]; }
            float A = p[3], H = h[3];
            { const float A1 = __shfl_up(A, 16), H1 = __shfl_up(H, 16); if (q4 >= 1) { H = A * H1 + H; A = A * A1; } }
            { const float A2 = __shfl_up(A, 32), H2 = __shfl_up(H, 32); if (q4 >= 2) { H = A * H2 + H; A = A * A2; } }
            float Ae = __shfl_up(A, 16), He = __shfl_up(H, 16); if (q4 == 0) { Ae = 1.f; He = 0.f; }
            const float Art = __shfl(A, 48 + d), Hrt = __shfl(H, 48 + d);
            const float hin = Ae * Hc + He, Pin = Ac * Ae;
#pragma unroll
            for (int j = 0; j < 4; ++j) { hl[rt][j] = p[j] * hin + h[j]; Pt[rt][j] = Pin * p[j]; }
            Hc = Art * Hc + Hrt; Ac = Ac * Art;
        }
        LAS float* agg = (LAS float*)(lds + R_AGG) + cur * 256;
        if (q4 == 0) { agg[wave * 32 + d] = Ac; agg[wave * 32 + 16 + d] = Hc; }
        if (tile + 1 < SEQ / RT) commit(lds + (cur ^ 1) * RB_SIZE);
        __syncthreads();
        float hin = tcarry, myh = 0.f;
#pragma unroll
        for (int w = 0; w < 8; ++w) { if (w == wave) myh = hin; hin = agg[w * 32 + d] * hin + agg[w * 32 + 16 + d]; }
        tcarry = hin;
#pragma unroll
        for (int rt = 0; rt < 2; ++rt) {
            const int tb = 32 * wave + 16 * rt; const size_t row0 = (size_t)b * SEQ + t0 + tb + 4 * q4;
            float s2[4];
#pragma unroll
            for (int j = 0; j < 4; ++j) { const float hv = hl[rt][j] + Pt[rt][j] * myh; const float y = gx[rt][j] * hv;
                ymix[(row0 + j) * DM + chd] = (bf16)f2bf(y); s2[j] = y * y; }
#pragma unroll
            for (int j = 0; j < 4; ++j) { s2[j] += __shfl_xor(s2[j], 1); s2[j] += __shfl_xor(s2[j], 2); s2[j] += __shfl_xor(s2[j], 4); s2[j] += __shfl_xor(s2[j], 8); }
            if (d == 0) *(f32x4*)(ssqr + (size_t)(cb * 4 + sl) * T + row0) = (f32x4){s2[0], s2[1], s2[2], s2[3]};
        }
    }
    __syncthreads();
}

constexpr int A_BUF = 18432;
constexpr int A_BIAS = 2 * A_BUF;
__device__ __forceinline__ void attn_item(Frame& F, int item) {
    const int h = item & 7, b = (item >> 3) & 7, cg = item >> 6, c0 = cg * 4;
    const int tid = F.tid, lane = F.lane, wave = F.wave, r32 = lane & 31, hi = lane >> 5;
    const int ci = wave >> 1, qb = wave & 1;
    const bf16* proj = (const bf16*)(F.ws + WS_PROJ);
    bf16* ymix = (bf16*)(F.ws + WS_YMIX); float* ssqa = (float*)(F.ws + WS_SSQA);
    LAS unsigned char* lds = F.lds;
    LAS float* bl = (LAS float*)(lds + A_BIAS);
    if (tid < 257) bl[tid] = F.in[11][h * 257 + tid];
    const float bfar = F.in[11][h * 257 + 256];
    const size_t qrow = (size_t)b * SEQ + (c0 + ci) * CHUNK + qb * 32 + r32;
    bf16x8 qf[4];
#pragma unroll
    for (int ks = 0; ks < 4; ++ks) qf[ks] = *(const bf16x8*)(proj + qrow * DIN + 1024 + h * HD + ks * 16 + hi * 8);
    f32x16 o[2];
#pragma unroll
    for (int i = 0; i < 2; ++i)
#pragma unroll
        for (int r = 0; r < 16; ++r) o[i][r] = 0.f;
    float mrun = -1e30f, lrun = 0.f;
    const int srow = tid >> 3, sc8 = tid & 7;
    const bf16* kvbase = proj + ((size_t)b * SEQ + srow) * DIN + 1536 + h * HD + sc8 * 8;
    const int j0 = c0 >= 8 ? 0 : 8 - c0;
    u32x4 pk, pv;
    { const bf16* p = kvbase + (size_t)(c0 - 8 + j0) * CHUNK * DIN; pk = *(const u32x4*)p; pv = *(const u32x4*)(p + 512); }
    *(LAS u32x4*)(lds + (j0 & 1) * A_BUF + srow * 144 + sc8 * 16) = pk; *(LAS u32x4*)(lds + (j0 & 1) * A_BUF + 9216 + srow * 144 + sc8 * 16) = pv;
    __syncthreads();
    for (int j = j0; j < 12; ++j) {
        const LAS unsigned char* kt = lds + (j & 1) * A_BUF; const LAS unsigned char* vt = kt + 9216;
        if (j + 1 < 12) { const bf16* p = kvbase + (size_t)(c0 - 8 + j + 1) * CHUNK * DIN; pk = *(const u32x4*)p; pv = *(const u32x4*)(p + 512); }
        if (j >= ci && j <= ci + 8) {
            f32x16 s[2];
#pragma unroll
            for (int kb = 0; kb < 2; ++kb) { f32x16 z;
#pragma unroll
                for (int r = 0; r < 16; ++r) z[r] = 0.f;
#pragma unroll
                for (int ks = 0; ks < 4; ++ks) { const bf16x8 kf = *(const LAS bf16x8*)(kt + (32 * kb + r32) * 144 + (16 * ks + 8 * hi) * 2); z = __builtin_amdgcn_mfma_f32_32x32x16_bf16(kf, qf[ks], z, 0, 0, 0); }
                s[kb] = z; }
            const int dc = ci + 8 - j;
            if (dc >= 3) {
#pragma unroll
                for (int kb = 0; kb < 2; ++kb)
#pragma unroll
                    for (int r = 0; r < 16; ++r) s[kb][r] += bfar;
            } else {
#pragma unroll
                for (int kb = 0; kb < 2; ++kb)
#pragma unroll
                    for (int r = 0; r < 16; ++r) { const int kk = kb * 32 + (r & 3) + 8 * (r >> 2) + 4 * hi; int dist = dc * 64 + qb * 32 + r32 - kk; dist = dist > 128 ? 128 : dist;
                        s[kb][r] += bl[dist + 128]; }
            }
            float mx = s[0][0];
#pragma unroll
            for (int r = 0; r < 16; ++r) { mx = fmaxf(mx, s[0][r]); mx = fmaxf(mx, s[1][r]); }
            mx = fmaxf(mx, __shfl_xor(mx, 32));
            const float mn = fmaxf(mrun, mx); const float alpha = __expf(mrun - mn); mrun = mn;
            float sum = 0.f;
#pragma unroll
            for (int kb = 0; kb < 2; ++kb)
#pragma unroll
                for (int r = 0; r < 16; ++r) { const float p = __expf(s[kb][r] - mn); s[kb][r] = p; sum += p; }
            lrun = lrun * alpha + sum;
#pragma unroll
            for (int db = 0; db < 2; ++db)
#pragma unroll
                for (int r = 0; r < 16; ++r) o[db][r] *= alpha;
#pragma unroll
            for (int kb = 0; kb < 2; ++kb)
#pragma unroll
                for (int s2 = 0; s2 < 2; ++s2) { u32x4 w;
                    w.x = pg8::cvt_pk_bf16(s[kb][8 * s2 + 0], s[kb][8 * s2 + 1]); w.y = pg8::cvt_pk_bf16(s[kb][8 * s2 + 2], s[kb][8 * s2 + 3]);
                    w.z = pg8::cvt_pk_bf16(s[kb][8 * s2 + 4], s[kb][8 * s2 + 5]); w.w = pg8::cvt_pk_bf16(s[kb][8 * s2 + 6], s[kb][8 * s2 + 7]);
                    const bf16x8 pf = __builtin_bit_cast(bf16x8, w);
#pragma unroll
                    for (int db = 0; db < 2; ++db) {
                        const int key0 = 32 * kb + 16 * s2 + 4 * hi, li = lane & 15, dg = (lane >> 4) & 1;
                        const LAS unsigned char* p0 = vt + (key0 + (li >> 2)) * 144 + (32 * db + 16 * dg + 4 * (li & 3)) * 2;
                        const s16x4 v0 = __builtin_bit_cast(s16x4, __builtin_amdgcn_ds_read_tr16_b64_v4i16((LAS s16x4*)p0));
                        const s16x4 v1 = __builtin_bit_cast(s16x4, __builtin_amdgcn_ds_read_tr16_b64_v4i16((LAS s16x4*)(p0 + 8 * 144)));
                        const bf16x8 vf = (bf16x8){v0[0], v0[1], v0[2], v0[3], v1[0], v1[1], v1[2], v1[3]};
                        o[db] = __builtin_amdgcn_mfma_f32_32x32x16_bf16(vf, pf, o[db], 0, 0, 0);
                    }
                }
        }
        if (j + 1 < 12) { LAS unsigned char* nb = lds + ((j + 1) & 1) * A_BUF; *(LAS u32x4*)(nb + srow * 144 + sc8 * 16) = pk; *(LAS u32x4*)(nb + 9216 + srow * 144 + sc8 * 16) = pv; }
        __syncthreads();
    }
    {
        const float l = lrun + __shfl_xor(lrun, 32); const float il = 1.0f / l; float s2 = 0.f;
#pragma unroll
        for (int db = 0; db < 2; ++db)
#pragma unroll
            for (int g4 = 0; g4 < 4; ++g4) { const float v0 = o[db][4 * g4 + 0] * il, v1 = o[db][4 * g4 + 1] * il, v2 = o[db][4 * g4 + 2] * il, v3 = o[db][4 * g4 + 3] * il;
                s2 += (v0 * v0 + v1 * v1) + (v2 * v2 + v3 * v3);
                u32x2 w; w.x = pg8::cvt_pk_bf16(v0, v1); w.y = pg8::cvt_pk_bf16(v2, v3);
                *(u32x2*)(ymix + qrow * DM + DRNN + h * HD + db * 32 + 8 * g4 + 4 * hi) = w; }
        s2 += __shfl_xor(s2, 32);
        if (hi == 0) ssqa[(size_t)h * T + qrow] = s2;
    }
}
constexpr int X_BUF = 33792;
__device__ __forceinline__ void xattn_item(Frame& F, int item) {
    const int b = item & 7, hd = (item >> 3) & 3, qt = item >> 5;
    const int lane = F.lane, wave = F.wave, tid = F.tid, r32 = lane & 31, hi = lane >> 5;
    const bf16* qx = (const bf16*)(F.ws + WS_QX); const bf16* kv = (const bf16*)(F.ws + WS_KV); bf16* O = (bf16*)(F.ws + WS_O);
    LAS unsigned char* lds = F.lds;
    const size_t qrow = (size_t)b * SEQ + qt * 256 + wave * 32 + r32;
    const bf16* qp = qx + qrow * DM + hd * XD + hi * 8;
    const bf16* sbase = kv + ((size_t)b * NMEM + (tid >> 5)) * 2048 + hd * XD + (tid & 31) * 8;
    u32x4 pre[4];
#define X_ISSUE(st) do { const bf16* sp_ = sbase + (size_t)(((st) & 3) * 64) * 2048 + ((st) >> 2) * 1024; _Pragma("unroll") for (int k_ = 0; k_ < 4; ++k_) pre[k_] = *(const u32x4*)(sp_ + (size_t)(16 * k_) * 2048); } while (0)
#define X_COMMIT(st) do { LAS unsigned char* db_ = lds + ((st) & 1) * X_BUF + (tid >> 5) * 528 + (tid & 31) * 16; _Pragma("unroll") for (int k_ = 0; k_ < 4; ++k_) *(LAS u32x4*)(db_ + 16 * k_ * 528) = pre[k_]; } while (0)
    X_ISSUE(0);
    bf16x8 qf[16];
#pragma unroll
    for (int ks = 0; ks < 16; ++ks) qf[ks] = *(const bf16x8*)(qp + ks * 16);
    __syncthreads();
    X_COMMIT(0);
    __syncthreads();
    f32x16 s[8];
#pragma unroll
    for (int st = 0; st < 4; ++st) {
        X_ISSUE(st + 1);
        const LAS unsigned char* kt = lds + (st & 1) * X_BUF;
#pragma unroll
        for (int kb2 = 0; kb2 < 2; ++kb2) { f32x16 z;
#pragma unroll
            for (int r = 0; r < 16; ++r) z[r] = 0.f;
#pragma unroll
            for (int ks = 0; ks < 16; ++ks) { const bf16x8 kf = *(const LAS bf16x8*)(kt + (32 * kb2 + r32) * 528 + (16 * ks + 8 * hi) * 2); z = __builtin_amdgcn_mfma_f32_32x32x16_bf16(kf, qf[ks], z, 0, 0, 0); }
            s[2 * st + kb2] = z; }
        X_COMMIT(st + 1);
        __syncthreads();
    }
    float mx = s[0][0];
#pragma unroll
    for (int kb = 0; kb < 8; ++kb)
#pragma unroll
        for (int r = 0; r < 16; ++r) mx = fmaxf(mx, s[kb][r]);
    mx = fmaxf(mx, __shfl_xor(mx, 32));
    float sum = 0.f;
    bf16x8 pf[8][2];
#pragma unroll
    for (int kb = 0; kb < 8; ++kb) {
#pragma unroll
        for (int r = 0; r < 16; ++r) { const float p = __expf(s[kb][r] - mx); s[kb][r] = p; sum += p; }
#pragma unroll
        for (int s2 = 0; s2 < 2; ++s2) { u32x4 w;
            w.x = pg8::cvt_pk_bf16(s[kb][8 * s2 + 0], s[kb][8 * s2 + 1]); w.y = pg8::cvt_pk_bf16(s[kb][8 * s2 + 2], s[kb][8 * s2 + 3]);
            w.z = pg8::cvt_pk_bf16(s[kb][8 * s2 + 4], s[kb][8 * s2 + 5]); w.w = pg8::cvt_pk_bf16(s[kb][8 * s2 + 6], s[kb][8 * s2 + 7]);
            pf[kb][s2] = __builtin_bit_cast(bf16x8, w); }
    }
    sum += __shfl_xor(sum, 32);
    const float il = 1.0f / sum;
    f32x16 o[8];
#pragma unroll
    for (int db = 0; db < 8; ++db)
#pragma unroll
        for (int r = 0; r < 16; ++r) o[db][r] = 0.f;
#pragma unroll
    for (int st = 4; st < 8; ++st) {
        if (st + 1 < 8) X_ISSUE(st + 1);
        const LAS unsigned char* vt = lds + (st & 1) * X_BUF;
#pragma unroll
        for (int kb2 = 0; kb2 < 2; ++kb2)
#pragma unroll
            for (int s2 = 0; s2 < 2; ++s2) {
                const int key0 = 32 * kb2 + 16 * s2 + 4 * hi, li = lane & 15, dg = (lane >> 4) & 1;
                const LAS unsigned char* pb = vt + (key0 + (li >> 2)) * 528 + (16 * dg + 4 * (li & 3)) * 2;
#pragma unroll
                for (int db = 0; db < 8; ++db) {
                    const s16x4 v0 = __builtin_bit_cast(s16x4, __builtin_amdgcn_ds_read_tr16_b64_v4i16((LAS s16x4*)(pb + db * 64)));
                    const s16x4 v1 = __builtin_bit_cast(s16x4, __builtin_amdgcn_ds_read_tr16_b64_v4i16((LAS s16x4*)(pb + db * 64 + 8 * 528)));
                    const bf16x8 vf = (bf16x8){v0[0], v0[1], v0[2], v0[3], v1[0], v1[1], v1[2], v1[3]};
                    o[db] = __builtin_amdgcn_mfma_f32_32x32x16_bf16(vf, pf[(st - 4) * 2 + kb2][s2], o[db], 0, 0, 0);
                }
            }
        if (st + 1 < 8) { X_COMMIT(st + 1); __syncthreads(); }
    }
#undef X_ISSUE
#undef X_COMMIT
    bf16* op = O + qrow * DM + hd * XD + 4 * hi;
#pragma unroll
    for (int db = 0; db < 8; ++db)
#pragma unroll
        for (int g4 = 0; g4 < 4; ++g4) { u32x2 w; w.x = pg8::cvt_pk_bf16(o[db][4 * g4 + 0] * il, o[db][4 * g4 + 1] * il); w.y = pg8::cvt_pk_bf16(o[db][4 * g4 + 2] * il, o[db][4 * g4 + 3] * il);
            *(u32x2*)(op + db * 32 + 8 * g4) = w; }
}

constexpr int RL_W = 0;
constexpr int RL_LOG = 99328;
constexpr int RL_CNT = RL_LOG + 20480;
__device__ __forceinline__ void p7_router(Frame& F) {
    const int lane = F.lane, wave = F.wave, tid = F.tid, fr = lane & 15, fq = lane >> 4;
    const bf16* xb = (const bf16*)(F.ws + WS_XB); const bf16* WrT = (const bf16*)(F.ws + WS_WR);
    const float* ssq2 = (const float*)(F.ws + WS_SSQ2);
    float* slotw = (float*)(F.ws + WS_SLOTW); int* list = (int*)(F.ws + WS_LIST);
    unsigned* gcnt = (unsigned*)(F.ws + WS_CTL) + CW_CNT;
    LAS float* lg = (LAS float*)(F.lds + RL_LOG) + wave * 16 * 40;
    LAS int* lcnt = (LAS int*)(F.lds + RL_CNT); LAS int* lbase = lcnt + 32;
#pragma unroll
    for (int k = 0; k < 12; ++k) { const int p = tid + 512 * k, row = p >> 7, c = p & 127;
        *(LAS u32x4*)(F.lds + RL_W + row * 2064 + c * 16) = *(const u32x4*)(WrT + (size_t)row * DM + c * 8); }
    for (int blk = blockIdx.x; blk < T / 128; blk += F.G) {
        const int tok0 = blk * 128 + wave * 16;
        if (tid < 32) lcnt[tid] = 0;
        __syncthreads();
        f32x4 c0 = {0.f, 0.f, 0.f, 0.f}, c1 = c0, c2 = c0;
        const bf16* ap = xb + (size_t)(tok0 + fr) * DM + fq * 8;
        const LAS unsigned char* bp = F.lds + RL_W + fr * 2064 + fq * 16;
#pragma unroll 8
        for (int ks = 0; ks < 32; ++ks) { const bf16x8 a = *(const bf16x8*)(ap + ks * 32);
            const bf16x8 b0 = *(const LAS bf16x8*)(bp + ks * 64), b1 = *(const LAS bf16x8*)(bp + 16 * 2064 + ks * 64), b2 = *(const LAS bf16x8*)(bp + 32 * 2064 + ks * 64);
            c0 = __builtin_amdgcn_mfma_f32_16x16x32_bf16(a, b0, c0, 0, 0, 0); c1 = __builtin_amdgcn_mfma_f32_16x16x32_bf16(a, b1, c1, 0, 0, 0); c2 = __builtin_amdgcn_mfma_f32_16x16x32_bf16(a, b2, c2, 0, 0, 0); }
#pragma unroll
        for (int j = 0; j < 4; ++j) { lg[(4 * fq + j) * 40 + fr] = c0[j]; lg[(4 * fq + j) * 40 + 16 + fr] = c1[j]; if (fr < 8) lg[(4 * fq + j) * 40 + 32 + fr] = c2[j]; }
        LDS_WAIT();
        int e0 = 0, e1 = 0; float w0 = 0.f, w1 = 0.f; int lp0 = 0, lp1 = 0;
        if (lane < 16) {
            const int tok = tok0 + lane; const RsPart16 rsp{ssq2}; const float rstd = rsp(tok);
            float gl[4]; int gi = 0;
#pragma unroll
            for (int j = 0; j < 4; ++j) gl[j] = lg[lane * 40 + j] * rstd + F.in[23][j];
            float gm = gl[0];
#pragma unroll
            for (int j = 1; j < 4; ++j) if (gl[j] > gm) { gm = gl[j]; gi = j; }
            float gs = 0.f;
#pragma unroll
            for (int j = 0; j < 4; ++j) gs += __expf(gl[j] - gm);
            const float gp = 1.0f / gs;
            float el[8];
#pragma unroll
            for (int j = 0; j < 8; ++j) el[j] = lg[lane * 40 + 4 + gi * 8 + j] * rstd + F.in[25][gi * 8 + j];
            int i0 = 0; float m0 = el[0];
#pragma unroll
            for (int j = 1; j < 8; ++j) if (el[j] > m0) { m0 = el[j]; i0 = j; }
            int i1 = -1; float m1 = -3.0e38f;
#pragma unroll
            for (int j = 0; j < 8; ++j) if (j != i0 && el[j] > m1) { m1 = el[j]; i1 = j; }
            const float p1 = __expf(m1 - m0); const float inv = 1.0f / (1.0f + p1);
            e0 = gi * 8 + i0; e1 = gi * 8 + i1; w0 = gp * inv; w1 = gp * p1 * inv;
            lp0 = atomicAdd((int*)&lcnt[e0], 1); lp1 = atomicAdd((int*)&lcnt[e1], 1);
            slotw[2 * tok] = w0; slotw[2 * tok + 1] = w1;
        }
        __syncthreads();
        if (tid < 32) lbase[tid] = (int)atomicAdd(&gcnt[tid], (unsigned)lcnt[tid]);
        __syncthreads();
        if (lane < 16) { const int tok = tok0 + lane;
            list[(size_t)e0 * T + lbase[e0] + lp0] = 2 * tok; list[(size_t)e1 * T + lbase[e1] + lp1] = 2 * tok + 1; }
        __syncthreads();
    }
}

__device__ __forceinline__ int moe_tables(Frame& F, LAS int* pref) {
    const unsigned* gcnt = (const unsigned*)(F.ws + WS_CTL) + CW_CNT;
    if (F.tid == 0) { int acc = 0; for (int e = 0; e < NE; ++e) { pref[e] = acc; acc += ((int)__hip_atomic_load(gcnt + e, RLX_AGENT) + 255) >> 8; } pref[NE] = acc; }
    __syncthreads();
    return pref[NE];
}
__device__ __forceinline__ void moe_fill_tok(Frame& F, const MoeOrder& S, LAS int* ltok, const LAS int* pref) {
    const unsigned* gcnt = (const unsigned*)(F.ws + WS_CTL) + CW_CNT; const int* list = (const int*)(F.ws + WS_LIST);
    pg8::Unit u;
    for (int i = 0; i < 8 && S.next(i, u); ++i) {
        if (F.tid < 256) { const int e = u.aux, r = (u.pm - pref[e]) * 256 + F.tid; const int cnt = (int)__hip_atomic_load(gcnt + e, RLX_AGENT);
            ltok[i * 256 + F.tid] = (r < cnt) ? list[(size_t)e * T + r] : -1; }
    }
    __syncthreads();
}
struct GatherG2 : GatherG {
    __device__ __forceinline__ void a_voff(const pg8::Unit& u, const int (&R)[2], const int (&C)[2], unsigned (&v)[2][2], const LAS int* ltok) const {
#pragma unroll
        for (int h = 0; h < 2; ++h)
#pragma unroll
            for (int i = 0; i < 2; ++i) { int sl = ltok[(u.idx & 7) * 256 + h * 128 + R[i]]; sl = sl < 0 ? 0 : sl; v[h][i] = (unsigned)((sl >> 1) * lda + C[i]) * 2u; }
    }
};

__device__ __forceinline__ void p10_final(Frame& F) {
    const int gw = F.vcu * NWAVES + F.wave, NGW = F.G * NWAVES, lane = F.lane;
    const bf16* Y = (const bf16*)(F.ws + WS_YSLOT); const bf16* XB = (const bf16*)(F.ws + WS_XB); float* out = F.out; const f32x4* fw = (const f32x4*)F.in[29] + lane;
    for (int m = gw; m < T; m += NGW) {
        f32x4* xo = (f32x4*)(out + (size_t)m * DM) + lane; const u32x2* xr = (const u32x2*)(XB + (size_t)m * DM) + lane;
        const u32x2* y0 = (const u32x2*)(Y + (size_t)(2 * m) * DM) + lane; const u32x2* y1 = (const u32x2*)(Y + (size_t)(2 * m + 1) * DM) + lane;
        f32x4 v[4]; float s = 0.f;
#pragma unroll
        for (int j = 0; j < 4; ++j) { const u32x2 x = xr[64 * j], a = y0[64 * j], c = y1[64 * j];
            v[j].x = bflo(x.x) + (bflo(a.x) + bflo(c.x)); v[j].y = bfhi(x.x) + (bfhi(a.x) + bfhi(c.x)); v[j].z = bflo(x.y) + (bflo(a.y) + bflo(c.y)); v[j].w = bfhi(x.y) + (bfhi(a.y) + bfhi(c.y));
            s += (v[j].x * v[j].x + v[j].y * v[j].y) + (v[j].z * v[j].z + v[j].w * v[j].w); }
        const float rstd = 1.0f / sqrtf(wave_sum(s) * (1.0f / DM) + EPS);
#pragma unroll
        for (int j = 0; j < 4; ++j) { const f32x4 w = fw[64 * j]; xo[64 * j] = v[j] * rstd * w; }
    }
}

constexpr int N_PHASES = 12;
__global__ void __launch_bounds__(NTHR, 2) hymba_fwd(Args args) {
    extern __shared__ __attribute__((aligned(16))) unsigned char lds_raw[];
    Frame F;
    F.lds = (LAS unsigned char*)lds_raw;
    F.tid = threadIdx.x; F.lane = F.tid & 63; F.wave = __builtin_amdgcn_readfirstlane(F.tid >> 6);
    F.G = gridDim.x; { const int bx = blockIdx.x; F.vcu = (F.G % 8 == 0) ? (bx % 8) * (F.G / 8) + bx / 8 : bx; }
    F.in = args.in; F.ws = args.ws; F.out = args.out;
    unsigned char* ws = args.ws;
    volatile LAS unsigned* MISC = (volatile LAS unsigned*)(F.lds + LDS_MISC);
    LAS int* ltok = (LAS int*)(F.lds + LDS_TOK);
    LAS int* pref = (LAS int*)(F.lds + LDS_MISC + 256);
    if (F.tid < 64) MISC[F.tid] = 0u;
    __syncthreads();
    XcdBarrier bar; bar.bar = (unsigned*)(ws + WS_CTL) + CW_BAR; bar.x = 0; bar.st = nullptr; bar.w = 0;
    if (MK_N_LAUNCHES == 1) bar = xcd_barrier_post((unsigned*)(ws + WS_CTL) + CW_BAR, MISC + 8, F.wave);
    const int lo = args.ph_lo, hi = args.ph_hi;
#ifndef PH_MASK
#define PH_MASK 0xfff
#endif
#define IN(k) (((PH_MASK >> (k)) & 1) && lo <= (k) && (k) < hi && (F.lane = hw_lane(), F.tid = F.wave * 64 + F.lane, true))
#define SEAM(k) do { if (IN(k) && IN((k) + 1)) xcd_barrier(bar); } while (0)
#ifndef PH_TWICE
#define PH_TWICE 0
#endif
#define REP(k)

    if (IN(0)) REP(0) { p0_prologue(F); } SEAM(0);
    if (IN(1)) REP(1) {
        { pg8::DenseG g{(const bf16*)(ws + WS_XB), (const bf16*)(ws + WS_WIN), DM, DM, DM / 64, 0}; pg8::StaticOrder S; S.init(T, DIN, F.G, (int)blockIdx.x);
          EpiBf16<RsArr> E{(bf16*)(ws + WS_PROJ), DIN, RsArr{(const float*)(ws + WS_RSTD1)}};
          pg8::gemm_phase<pg8::DenseG, EpiBf16<RsArr>, pg8::StaticOrder, true>(F.lds, ltok, g, S, E, F.wave); }
        { pg8::DenseG g{(const bf16*)(ws + WS_MEMN), (const bf16*)(ws + WS_WKV), DM, DM, DM / 64, 0}; pg8::StaticOrder S; S.init(MT, 2048, F.G, (int)blockIdx.x);
          EpiBf16<RsNone> E{(bf16*)(ws + WS_KV), 2048, RsNone{}};
          pg8::gemm_phase<pg8::DenseG, EpiBf16<RsNone>, pg8::StaticOrder, true>(F.lds, ltok, g, S, E, F.wave); }
    } SEAM(1);
    if (IN(2)) {
        for (int it = blockIdx.x; it < 256; it += F.G) rnn_item(F, it);
        for (int it = blockIdx.x; it < BATCH * NH * (NCHUNK / 4); it += F.G) attn_item(F, it);
    }
    if (IN(3)) { } SEAM(3);
    if (IN(4)) REP(4) {
        pg8::DenseG g{(const bf16*)(ws + WS_YMIX), (const bf16*)(ws + WS_WOUT), DM, DM, 8, 512}; pg8::TwoHalfOrder S; S.s.init(T, DM, F.G, (int)blockIdx.x);
        p3_scale_table(F, S.s, (LAS float*)(F.lds + LDS_TOK));
        EpiRes<true, false> E{F.in[0], (bf16*)(ws + WS_XB), (float*)(ws + WS_SSQ1), (const LAS float*)(F.lds + LDS_TOK)};
        pg8::gemm_phase<pg8::DenseG, EpiRes<true, false>, pg8::TwoHalfOrder, true>(F.lds, ltok, g, S, E, F.wave);
    } SEAM(4);
    if (IN(5)) REP(5) {
        pg8::DenseG g{(const bf16*)(ws + WS_XB), (const bf16*)(ws + WS_WQ), DM, DM, DM / 64, 0}; pg8::StaticOrder S; S.init(T, DM, F.G, (int)blockIdx.x);
        EpiBf16<RsPart16> E{(bf16*)(ws + WS_QX), DM, RsPart16{(const float*)(ws + WS_SSQ1)}};
        pg8::gemm_phase<pg8::DenseG, EpiBf16<RsPart16>, pg8::StaticOrder, true>(F.lds, ltok, g, S, E, F.wave);
    } SEAM(5);
    if (IN(6)) REP(6) { for (int it = blockIdx.x; it < BATCH * XH * (SEQ / 256); it += F.G) xattn_item(F, it); } SEAM(6);
    if (IN(7)) REP(7) {
        pg8::DenseG g{(const bf16*)(ws + WS_O), (const bf16*)(ws + WS_WO), DM, DM, DM / 64, 0}; pg8::StaticOrder S; S.init(T, DM, F.G, (int)blockIdx.x);
        EpiRes<false, true> E{nullptr, (bf16*)(ws + WS_XB), (float*)(ws + WS_SSQ2), (const LAS float*)(F.lds + LDS_TOK)};
        pg8::gemm_phase<pg8::DenseG, EpiRes<false, true>, pg8::StaticOrder, true>(F.lds, ltok, g, S, E, F.wave);
    } SEAM(7);
    if (IN(8)) REP(8) { p7_router(F); } SEAM(8);
    if (IN(9)) REP(9) {
        const int ntile = moe_tables(F, pref);
        MoeOrder S{pref, F.G, (int)blockIdx.x, ntile};
        moe_fill_tok(F, S, ltok, pref);
        GatherG2 g; g.A = (const bf16*)(ws + WS_XB); g.Bt = (const bf16*)(ws + WS_WGU); g.lda = DM; g.ldb = DM; g.nt = DM / 64;
        EpiGateUp E{(bf16*)(ws + WS_HID), ltok, RsPart16{(const float*)(ws + WS_SSQ2)}};
        pg8::gemm_phase<GatherG2, EpiGateUp, MoeOrder, true>(F.lds, ltok, g, S, E, F.wave);
    } SEAM(9);
    if (IN(10)) REP(10) {
        const int ntile = moe_tables(F, pref);
        MoeOrder S{pref, F.G, (int)blockIdx.x, ntile};
        moe_fill_tok(F, S, ltok, pref);
        DownG g{(const bf16*)(ws + WS_HID), (const bf16*)(ws + WS_WD), DE, DE, DE / 64};
        EpiDown E{(bf16*)(ws + WS_YSLOT), (const float*)(ws + WS_SLOTW), ltok};
        pg8::gemm_phase<DownG, EpiDown, MoeOrder, true>(F.lds, ltok, g, S, E, F.wave);
    } SEAM(10);
    if (IN(11)) REP(11) { p10_final(F); }
#undef IN
#undef SEAM
}

extern "C" void kernel_launch(void* const* d_in, const int* in_sizes, int n_in, void* d_out, int out_size, void* d_ws, size_t ws_size, hipStream_t stream) {
    static int grid = 0;
    if (grid == 0) {
        if (n_in != 30 || in_sizes[0] != T * DM || out_size != T * DM || ws_size < WS_END) {
            fprintf(stderr, "kernel_launch: unexpected shapes: n_in %d in0 %d out %d ws %zu (need %zu)\n", n_in, n_in > 0 ? in_sizes[0] : -1, out_size, ws_size, (size_t)WS_END); grid = -1; return; }
        int dev = 0, cus = 0, per_cu = 0;
        if (hipGetDevice(&dev) != hipSuccess || hipDeviceGetAttribute(&cus, hipDeviceAttributeMultiprocessorCount, dev) != hipSuccess) { grid = -1; return; }
        if (hipFuncSetAttribute((const void*)hymba_fwd, hipFuncAttributeMaxDynamicSharedMemorySize, LDS_BYTES) != hipSuccess) { fprintf(stderr, "kernel_launch: hipFuncSetAttribute failed\n"); grid = -1; return; }
        if (hipOccupancyMaxActiveBlocksPerMultiprocessor(&per_cu, (const void*)hymba_fwd, NTHR, LDS_BYTES) != hipSuccess || per_cu < 1) { fprintf(stderr, "kernel_launch: occupancy query failed (%d)\n", per_cu); (void)hipGetLastError(); grid = -1; return; }
        grid = cus;
    }
    if (grid < 0) return;
    (void)hipMemsetAsync((char*)d_ws + WS_CTL, 0, CTL_ZERO_BYTES, stream);
    Args a{};
    for (int i = 0; i < 30; ++i) a.in[i] = (const float*)d_in[i];
    a.out = (float*)d_out; a.ws = (unsigned char*)d_ws;
    if (MK_N_LAUNCHES == 1) {
        a.ph_lo = 0; a.ph_hi = N_PHASES;
        void* kargs[] = {&a};
        hipError_t e = hipLaunchCooperativeKernel((const void*)hymba_fwd, dim3(grid), dim3(NTHR), kargs, LDS_BYTES, stream);
        if (e != hipSuccess) fprintf(stderr, "cooperative launch failed: %s (grid %d)\n", hipGetErrorString(e), grid);
    } else {
        for (int p = 0; p < N_PHASES; ++p) { a.ph_lo = p; a.ph_hi = p + 1;
            for (int rep = 0; rep < ((p == PH_DUP) ? 2 : 1); ++rep) hipLaunchKernelGGL(hymba_fwd, dim3(grid), dim3(NTHR), LDS_BYTES, stream, a); }
    }
}
```
